# Optimizing an MI355X kernel written in HIP

```python
import jax, jax.numpy as jnp
from jax import lax
import numpy as np

D_MODEL = 2048
BATCH = 2
SEQ = 4096
DEPTH = 1

D_POOL = D_MODEL // 2
N_POOL_GROUPS = 4
POOL_GROUP = D_POOL // N_POOL_GROUPS
POOL_WINDOWS = (2, 4, 8, 16)
D_CONV = D_MODEL // 2
CONV_WIDTH = 31
D_FF = 5632
N_BRANCHES = 2
D_IN = D_POOL + 2 * D_CONV + N_BRANCHES * D_MODEL
EPS = 1e-6

kernel_name = "macaron_gated_pool_conv_encoder"


def rmsnorm(x, g):
    xf = x.astype(jnp.float32)
    y = xf * lax.rsqrt(jnp.mean(xf * xf, axis=-1, keepdims=True) + EPS)
    return (y * g.astype(jnp.float32)).astype(x.dtype)


def layernorm(x, g, b):
    xf = x.astype(jnp.float32)
    mu = jnp.mean(xf, axis=-1, keepdims=True)
    var = jnp.mean(jnp.square(xf - mu), axis=-1, keepdims=True)
    y = (xf - mu) * lax.rsqrt(var + EPS)
    return (y * g.astype(jnp.float32) + b.astype(jnp.float32)).astype(x.dtype)


def swiglu(h, w_gate, w_up, w_down):
    return (jax.nn.silu(h @ w_gate) * (h @ w_up)) @ w_down


def centred_window_mean(u, w):
    T = u.shape[1]
    cs = jnp.cumsum(u.astype(jnp.float32), axis=1)
    cs = jnp.pad(cs, ((0, 0), (1, 0), (0, 0)))
    t = jnp.arange(T)
    lo = jnp.clip(t - w // 2, 0, T)
    hi = jnp.clip(t + (w - w // 2), 0, T)
    count = (hi - lo).astype(jnp.float32)
    s = jnp.take(cs, hi, axis=1) - jnp.take(cs, lo, axis=1)
    return (s / count[None, :, None]).astype(u.dtype)


def pool_branch(u, w_group, scale, w_proj):
    B, T, _ = u.shape
    ug = u.reshape(B, T, N_POOL_GROUPS, POOL_GROUP)
    pooled = jnp.stack(
        [centred_window_mean(ug[:, :, gi], w) - ug[:, :, gi] for gi, w in enumerate(POOL_WINDOWS)],
        axis=2)
    mixed = jnp.einsum('btgc,gcd->btgd', pooled, w_group)
    mixed = mixed.reshape(B, T, D_POOL) * scale
    return mixed @ w_proj


def conv_branch(v, dw_w, dw_b, ln_g, ln_b, w_proj, b_proj):
    v1, v2 = jnp.split(v, 2, axis=-1)
    glu = v1 * jax.nn.sigmoid(v2)
    conv = lax.conv_general_dilated(
        glu, dw_w.reshape(CONV_WIDTH, 1, D_CONV).astype(glu.dtype),
        window_strides=(1,), padding='SAME',
        dimension_numbers=('NWC', 'WIO', 'NWC'),
        feature_group_count=D_CONV) + dw_b
    y = jax.nn.silu(layernorm(conv, ln_g, ln_b))
    return y @ w_proj + b_proj


def setup_inputs(seed: int = 0) -> dict:
    key = jax.random.key(seed)
    ks = iter(jax.random.split(key, 32))
    f32 = jnp.float32

    def nrm(shape, fan_in):
        return jax.random.normal(next(ks), shape, f32) * (fan_in ** -0.5)

    def gain(shape):
        return 1.0 + 0.02 * jax.random.normal(next(ks), shape, f32)

    def bias(shape):
        return 0.02 * jax.random.normal(next(ks), shape, f32)

    L = DEPTH
    return {
        "x": jax.random.normal(next(ks), (BATCH, SEQ, D_MODEL), f32),
        "ffn1_norm": gain((L, D_MODEL)),
        "ffn1_w_gate": nrm((L, D_MODEL, D_FF), D_MODEL),
        "ffn1_w_up": nrm((L, D_MODEL, D_FF), D_MODEL),
        "ffn1_w_down": nrm((L, D_FF, D_MODEL), D_FF),
        "mix_norm": gain((L, D_MODEL)),
        "w_in": nrm((L, D_MODEL, D_IN), D_MODEL),
        "b_gate": bias((L, N_BRANCHES * D_MODEL)),
        "pool_w_group": nrm((L, N_POOL_GROUPS, POOL_GROUP, POOL_GROUP), POOL_GROUP),
        "pool_scale": gain((L, D_POOL)),
        "pool_w_proj": nrm((L, D_POOL, D_MODEL), D_POOL),
        "conv_dw_w": nrm((L, CONV_WIDTH, D_CONV), CONV_WIDTH),
        "conv_dw_b": bias((L, D_CONV)),
        "conv_ln_g": gain((L, D_CONV)),
        "conv_ln_b": bias((L, D_CONV)),
        "conv_w_proj": nrm((L, D_CONV, D_MODEL), D_CONV),
        "conv_b_proj": bias((L, D_MODEL)),
        "w_out": nrm((L, D_MODEL, D_MODEL), D_MODEL),
        "ffn2_norm": gain((L, D_MODEL)),
        "ffn2_w_gate": nrm((L, D_MODEL, D_FF), D_MODEL),
        "ffn2_w_up": nrm((L, D_MODEL, D_FF), D_MODEL),
        "ffn2_w_down": nrm((L, D_FF, D_MODEL), D_FF),
        "final_norm": gain((D_MODEL,)),
    }


def reference(x, ffn1_norm, ffn1_w_gate, ffn1_w_up, ffn1_w_down, mix_norm, w_in, b_gate,
              pool_w_group, pool_scale, pool_w_proj, conv_dw_w, conv_dw_b, conv_ln_g,
              conv_ln_b, conv_w_proj, conv_b_proj, w_out, ffn2_norm, ffn2_w_gate,
              ffn2_w_up, ffn2_w_down, final_norm):
    for l in range(DEPTH):
        x = x + 0.5 * swiglu(rmsnorm(x, ffn1_norm[l]), ffn1_w_gate[l], ffn1_w_up[l], ffn1_w_down[l])
        h = rmsnorm(x, mix_norm[l])
        z = h @ w_in[l]
        u = z[..., :D_POOL]
        v = z[..., D_POOL:D_POOL + 2 * D_CONV]
        g_logits = z[..., D_POOL + 2 * D_CONV:] + b_gate[l]
        a = pool_branch(u, pool_w_group[l], pool_scale[l], pool_w_proj[l])
        b = conv_branch(v, conv_dw_w[l], conv_dw_b[l], conv_ln_g[l], conv_ln_b[l],
                        conv_w_proj[l], conv_b_proj[l])
        g_a, g_b = jnp.split(jax.nn.sigmoid(g_logits), N_BRANCHES, axis=-1)
        x = x + (g_a * a + g_b * b) @ w_out[l]
        x = x + 0.5 * swiglu(rmsnorm(x, ffn2_norm[l]), ffn2_w_gate[l], ffn2_w_up[l], ffn2_w_down[l])
    return rmsnorm(x, final_norm)
```

```cpp
#include <hip/hip_runtime.h>
#include <hip/hip_cooperative_groups.h>
#include <cstdio>
#include <cstdint>
namespace cg = cooperative_groups;
#define MK_N_LAUNCHES 1

namespace pg8 {
#define PG8_LAS __attribute__((address_space(3)))
typedef unsigned short bf16_t;
typedef short bf16x8 __attribute__((ext_vector_type(8)));
typedef float f32x4 __attribute__((ext_vector_type(4)));
typedef unsigned u32x4 __attribute__((ext_vector_type(4)));
constexpr int BM = 256, BK = 64, HALF = 128, HTB = HALF * BK * 2  , STAGE_BYTES = 8 * HTB, NXCD = 8, WGM = 4;

__host__ __device__ __forceinline__ int lds_byte(int r, int c) { const int st = (r >> 4) * 2 + (c >> 5), rr = r & 15, cc = c & 31, ob = rr * 64 + cc * 2; return st * 1024 + (ob ^ (((ob >> 9) & 1) << 5)); }
__host__ __device__ __forceinline__ void stage_rc(int b, int& R, int& C) { const int st = b / 1024, sb = b % 1024, swz = sb ^ (((sb >> 9) & 1) << 5); R = (st >> 1) * 16 + swz / 64; C = (st & 1) * 32 + (swz % 64) / 2; }
__host__ __device__ __forceinline__ int perm32(int rho) { const int n = rho >> 4, i = rho & 15; return 8 * (i >> 2) + 4 * n + (i & 3); }

struct Unit { int pm, pn; };
struct Gemm { const bf16_t* A; const bf16_t* Bt; int M, N, K; };

struct StaticOrder {
    int nM, nN, nwg, G, c;
    __host__ __device__ void init(int M, int N, int G_, int c_) { nM = M / BM; nN = N / BM; nwg = nM * nN; G = G_; c = c_; }
    __host__ __device__ bool next(int i, Unit& u) const {
        const long L = (long)i * G + c; if (L >= nwg) return false;
        int wgid = (int)L; { const int q = nwg / NXCD, r = nwg % NXCD, xcd = wgid % NXCD, off = wgid / NXCD; wgid = (xcd < r ? xcd * (q + 1) : r * (q + 1) + (xcd - r) * q) + off; }
        const int nig = WGM * nN, gid = wgid / nig, fm = gid * WGM, gsz = (nM - fm) < WGM ? (nM - fm) : WGM;
        u.pm = fm + ((wgid % nig) % gsz); u.pn = (wgid % nig) / gsz; return true;
    }
    __device__ __forceinline__ void a_ready(const Unit&) const {}
    __device__ __forceinline__ void done(const Unit&) const {}
};

typedef __bf16 bf16x2_t __attribute__((ext_vector_type(2)));
typedef float f32x2 __attribute__((ext_vector_type(2)));
__device__ __forceinline__ unsigned cvt_pk_bf16(float lo, float hi) { const f32x2 f = {lo, hi}; return __builtin_bit_cast(unsigned, __builtin_convertvector(f, bf16x2_t)); }
template <class Epi, class Sched, bool ALIGN_EPI = false, bool SP2 = false>
__device__ __forceinline__ void gemm_phase(PG8_LAS unsigned char* lds, const Gemm g, const Sched& S, const Epi& E) {
    const int tid = threadIdx.x, wid = __builtin_amdgcn_readfirstlane(tid >> 6), lane = tid & 63, wr = wid >> 2, wc = wid & 3, fr = lane & 15, fq = lane >> 4;
    const int K = g.K, nt = K / BK;
    unsigned voffA[2], voffB[2];
#pragma unroll
    for (int i = 0; i < 2; ++i) { int R, C; stage_rc(tid * 16 + i * 8192, R, C); const int Rb = Epi::PERM ? ((R & ~31) + perm32(R & 31)) : R;
        voffA[i] = (unsigned)(R * K + C) * 2u; voffB[i] = (unsigned)(Rb * K + C) * 2u; }
    const size_t kstep = (size_t)(BK * 2);
    const size_t hstep = (size_t)HALF * K * 2;
    const size_t tstep = 2 * hstep;
    const unsigned ldsw = (unsigned)wid * 1024u;
    const int aoff = lds_byte(wr * 64 + fr, fq * 8), boff = lds_byte(wc * 32 + fr, fq * 8);
#define PG8_SA(b, h) (((b) * 2 + (h)) * HTB)
#define PG8_SB(b, h) ((4 + (b) * 2 + (h)) * HTB)
#define PG8_STAGE(bufoff, gbase, voff) do { _Pragma("unroll") for (int _i = 0; _i < 2; ++_i) \
        __builtin_amdgcn_global_load_lds((const unsigned*)((const char*)(gbase) + (voff)[_i]), (PG8_LAS unsigned*)(lds + (bufoff) + ldsw + _i * 8192), 16, 0, 0); } while (0)
#define PG8_LDA(dst, b, h) do { _Pragma("unroll") for (int m = 0; m < 4; ++m) _Pragma("unroll") for (int k = 0; k < 2; ++k) dst[m][k] = *(const PG8_LAS bf16x8*)(lds + PG8_SA(b, h) + aoff + m * 2048 + k * 1024); } while (0)
#define PG8_LDB(dst, b, h) do { _Pragma("unroll") for (int n = 0; n < 2; ++n) _Pragma("unroll") for (int k = 0; k < 2; ++k) dst[n][k] = *(const PG8_LAS bf16x8*)(lds + PG8_SB(b, h) + boff + n * 2048 + k * 1024); } while (0)
#define PG8_MMA(ai, bj, At, Bt) do { __builtin_amdgcn_s_setprio(1); _Pragma("unroll") for (int m = 0; m < 4; ++m) _Pragma("unroll") for (int n = 0; n < 2; ++n) _Pragma("unroll") for (int k = 0; k < 2; ++k) \
        acc[ai][bj][m][n] = __builtin_amdgcn_mfma_f32_16x16x32_bf16(Bt[n][k], At[m][k], acc[ai][bj][m][n], 0, 0, 0); __builtin_amdgcn_s_setprio(0); } while (0)
#define PG8_WAIT_V(n) asm volatile("s_waitcnt vmcnt(" #n ")" ::: "memory")
#define PG8_WAIT_L(n) asm volatile("s_waitcnt lgkmcnt(" #n ")" ::: "memory")
#define PG8_BAR __builtin_amdgcn_s_barrier()
#define PG8_SCHED __builtin_amdgcn_sched_barrier(0)
    Unit cur, nxt; int ui = 0;
    if (!S.next(0, cur)) return;
    f32x4 acc[2][2][4][2];
#pragma unroll
    for (int a = 0; a < 2; ++a)
#pragma unroll
        for (int b = 0; b < 2; ++b)
#pragma unroll
            for (int m = 0; m < 4; ++m)
#pragma unroll
                for (int n = 0; n < 2; ++n) acc[a][b][m][n] = (f32x4){0.f, 0.f, 0.f, 0.f};
    bf16x8 At[4][2], B0[2][2], B1[2][2];
    const char* cA = (const char*)g.A + (size_t)cur.pm * tstep; const char* cB = (const char*)g.Bt + (size_t)cur.pn * tstep;
    S.a_ready(cur);
    if constexpr (SP2) {
        PG8_STAGE(PG8_SB(0, 0), cB, voffB); PG8_STAGE(PG8_SB(0, 1), cB + hstep, voffB); PG8_STAGE(PG8_SA(0, 0), cA, voffA); PG8_STAGE(PG8_SA(0, 1), cA + hstep, voffA);
        if (wr == 1) PG8_BAR;
        PG8_WAIT_V(2); PG8_BAR;
        PG8_STAGE(PG8_SB(1, 0), cB + kstep, voffB); PG8_STAGE(PG8_SA(1, 0), cA + kstep, voffA); PG8_STAGE(PG8_SB(1, 1), cB + hstep + kstep, voffB);
        PG8_WAIT_V(6); PG8_BAR;
    } else {
        PG8_STAGE(PG8_SB(0, 0), cB, voffB); PG8_STAGE(PG8_SA(0, 0), cA, voffA); PG8_STAGE(PG8_SB(0, 1), cB + hstep, voffB); PG8_STAGE(PG8_SA(0, 1), cA + hstep, voffA);
        if (wr == 1) PG8_BAR;
        PG8_WAIT_V(4); PG8_BAR;
        PG8_STAGE(PG8_SB(1, 0), cB + kstep, voffB); PG8_STAGE(PG8_SA(1, 0), cA + kstep, voffA); PG8_STAGE(PG8_SB(1, 1), cB + hstep + kstep, voffB);
        PG8_WAIT_V(6); PG8_BAR;
    }
    for (;;) {
        const bool has_next = S.next(ui + 1, nxt);
        const char* nA = has_next ? (const char*)g.A + (size_t)nxt.pm * tstep : cA; const char* nB = has_next ? (const char*)g.Bt + (size_t)nxt.pn * tstep : cB;
        for (int t = 0; t < nt; t += 2) {
            const bool last = (t == nt - 2);
            const char* a1 = cA + (size_t)(t + 1) * kstep;
            const char* a2 = last ? nA : cA + (size_t)(t + 2) * kstep; const char* b2 = last ? nB : cB + (size_t)(t + 2) * kstep;
            const char* a3 = a2 + kstep; const char* b3 = b2 + kstep;
            if (last && has_next) S.a_ready(nxt);
            if constexpr (SP2) {
            PG8_LDB(B0, 0, 0); PG8_LDB(B1, 0, 1); PG8_SCHED; PG8_LDA(At, 0, 0); PG8_STAGE(PG8_SA(1, 1), a1 + hstep, voffA);
            PG8_WAIT_V(8); PG8_WAIT_L(0); PG8_BAR; PG8_MMA(0, 0, At, B0); PG8_MMA(0, 1, At, B1); PG8_BAR; PG8_SCHED;
            PG8_LDA(At, 0, 1); PG8_STAGE(PG8_SB(0, 0), b2, voffB); PG8_STAGE(PG8_SB(0, 1), b2 + hstep, voffB); PG8_STAGE(PG8_SA(0, 0), a2, voffA);
            PG8_WAIT_V(8); PG8_WAIT_L(0); PG8_BAR; PG8_MMA(1, 0, At, B0); PG8_MMA(1, 1, At, B1); PG8_BAR; PG8_SCHED;
            PG8_LDB(B0, 1, 0); PG8_LDB(B1, 1, 1); PG8_SCHED; PG8_LDA(At, 1, 0); PG8_STAGE(PG8_SA(0, 1), a2 + hstep, voffA);
            PG8_WAIT_V(8); PG8_WAIT_L(0); PG8_BAR; PG8_MMA(0, 0, At, B0); PG8_MMA(0, 1, At, B1); PG8_BAR; PG8_SCHED;
            PG8_LDA(At, 1, 1); PG8_STAGE(PG8_SB(1, 0), b3, voffB); PG8_STAGE(PG8_SB(1, 1), b3 + hstep, voffB); PG8_STAGE(PG8_SA(1, 0), a3, voffA);
            PG8_WAIT_V(8); PG8_WAIT_L(0); PG8_BAR; PG8_MMA(1, 0, At, B0); PG8_MMA(1, 1, At, B1); PG8_BAR; PG8_SCHED;
            } else {
            PG8_LDB(B0, 0, 0); PG8_SCHED; PG8_LDA(At, 0, 0); PG8_STAGE(PG8_SA(1, 1), a1 + hstep, voffA);
            PG8_WAIT_L(8); PG8_BAR; PG8_WAIT_L(0); PG8_MMA(0, 0, At, B0); PG8_BAR; PG8_SCHED;
            PG8_LDB(B1, 0, 1); PG8_STAGE(PG8_SB(0, 0), b2, voffB);
            PG8_BAR; PG8_WAIT_L(0); PG8_MMA(0, 1, At, B1); PG8_BAR;
            PG8_LDA(At, 0, 1); PG8_STAGE(PG8_SA(0, 0), a2, voffA);
            PG8_BAR; PG8_WAIT_L(0); PG8_MMA(1, 0, At, B0); PG8_BAR; PG8_SCHED;
            PG8_STAGE(PG8_SB(0, 1), b2 + hstep, voffB);
            PG8_WAIT_V(6); PG8_BAR; PG8_MMA(1, 1, At, B1); PG8_BAR;
            PG8_LDB(B0, 1, 0); PG8_SCHED; PG8_LDA(At, 1, 0); PG8_STAGE(PG8_SA(0, 1), a2 + hstep, voffA);
            PG8_WAIT_L(8); PG8_BAR; PG8_WAIT_L(0); PG8_MMA(0, 0, At, B0); PG8_BAR; PG8_SCHED;
            PG8_LDB(B1, 1, 1); PG8_STAGE(PG8_SB(1, 0), b3, voffB);
            PG8_BAR; PG8_WAIT_L(0); PG8_MMA(0, 1, At, B1); PG8_BAR;
            PG8_LDA(At, 1, 1); PG8_STAGE(PG8_SA(1, 0), a3, voffA);
            PG8_BAR; PG8_WAIT_L(0); PG8_MMA(1, 0, At, B0); PG8_BAR; PG8_SCHED;
            PG8_STAGE(PG8_SB(1, 1), b3 + hstep, voffB);
            PG8_WAIT_V(6); PG8_BAR; PG8_MMA(1, 1, At, B1); PG8_BAR;
            }
        }
        if constexpr (ALIGN_EPI) { if (wr == 0) PG8_BAR; }
        if constexpr (!Epi::AFTER_DRAIN) { E(acc, cur, wr, wc, fr, fq); S.done(cur); }
        if (!has_next) break;
#pragma unroll
        for (int a = 0; a < 2; ++a)
#pragma unroll
            for (int b = 0; b < 2; ++b)
#pragma unroll
                for (int m = 0; m < 4; ++m)
#pragma unroll
                    for (int n = 0; n < 2; ++n) acc[a][b][m][n] = (f32x4){0.f, 0.f, 0.f, 0.f};
        cur = nxt; cA = nA; cB = nB; ++ui;
        if constexpr (ALIGN_EPI) { if (wr == 1) PG8_BAR; }
    }
    PG8_WAIT_V(0);
    if constexpr (!ALIGN_EPI) { if (wr == 0) PG8_BAR; }
    PG8_BAR;
    if constexpr (Epi::AFTER_DRAIN) { E.fused(acc, cur, wr, wc, fr, fq, lds, wid, lane); S.done(cur); }
#undef PG8_SA
#undef PG8_SB
#undef PG8_STAGE
#undef PG8_LDA
#undef PG8_LDB
#undef PG8_MMA
#undef PG8_WAIT_V
#undef PG8_WAIT_L
#undef PG8_BAR
#undef PG8_SCHED
}
}

namespace pg8 {
__device__ __forceinline__ float fsigmoid(float x) { return __builtin_amdgcn_rcpf(1.0f + __builtin_amdgcn_exp2f(x * -1.44269504089f)); }
__device__ __forceinline__ float bflo(unsigned w) { return __uint_as_float(w << 16); }
__device__ __forceinline__ float bfhi(unsigned w) { return __uint_as_float(w & 0xffff0000u); }
constexpr float RMS_EPS = 1e-6f;

struct EpiSwiglu {
    static constexpr bool PERM = true, AFTER_DRAIN = false;
    bf16_t* O; int ldo; const float* ssq; float invd;
    __device__ __forceinline__ void operator()(const f32x4 (&acc)[2][2][4][2], const Unit& u, int wr, int wc, int fr, int fq) const {
        const int row0 = u.pm * BM + wr * 64 + fr, col0 = u.pn * HALF + wc * 32 + 8 * fq;
#pragma unroll
        for (int ai = 0; ai < 2; ++ai)
#pragma unroll
            for (int m = 0; m < 4; ++m) {
                const int row = row0 + ai * HALF + m * 16;
                const float rs = __builtin_amdgcn_rsqf(ssq[row] * invd + RMS_EPS);
                float h[8];
#pragma unroll
                for (int n = 0; n < 2; ++n)
#pragma unroll
                    for (int i = 0; i < 4; ++i) { const float g = acc[ai][0][m][n][i] * rs, up = acc[ai][1][m][n][i] * rs; h[n * 4 + i] = g * fsigmoid(g) * up; }
                u32x4 w; w.x = cvt_pk_bf16(h[0], h[1]); w.y = cvt_pk_bf16(h[2], h[3]); w.z = cvt_pk_bf16(h[4], h[5]); w.w = cvt_pk_bf16(h[6], h[7]);
                *(u32x4*)(O + (size_t)row * ldo + col0) = w;
            }
    }
};

struct EpiResid {
    static constexpr bool PERM = true, AFTER_DRAIN = false;
    const float* base; float* out; bf16_t* ob; float* ssq_out; int ldc; float alpha;
    __device__ __forceinline__ void operator()(const f32x4 (&acc)[2][2][4][2], const Unit& u, int wr, int wc, int fr, int fq) const {
        const int row0 = u.pm * BM + wr * 64 + fr, col0 = u.pn * BM + wc * 32 + 8 * fq;
#pragma unroll
        for (int ai = 0; ai < 2; ++ai)
#pragma unroll
            for (int m = 0; m < 4; ++m) {
                const int row = row0 + ai * HALF + m * 16; float s = 0.f;
#pragma unroll
                for (int bj = 0; bj < 2; ++bj) {
                    const size_t off = (size_t)row * ldc + col0 + bj * HALF;
                    const f32x4 b0 = *(const f32x4*)(base + off), b1 = *(const f32x4*)(base + off + 4);
                    const f32x4 v0 = b0 + acc[ai][bj][m][0] * alpha, v1 = b1 + acc[ai][bj][m][1] * alpha;
                    *(f32x4*)(out + off) = v0; *(f32x4*)(out + off + 4) = v1;
                    s += (v0[0] * v0[0] + v0[1] * v0[1]) + (v0[2] * v0[2] + v0[3] * v0[3]) + (v1[0] * v1[0] + v1[1] * v1[1]) + (v1[2] * v1[2] + v1[3] * v1[3]);
                    if (ob) { u32x4 w; w.x = cvt_pk_bf16(v0[0], v0[1]); w.y = cvt_pk_bf16(v0[2], v0[3]); w.z = cvt_pk_bf16(v1[0], v1[1]); w.w = cvt_pk_bf16(v1[2], v1[3]); *(u32x4*)(ob + off) = w; }
                }
                s += __shfl_xor(s, 16); s += __shfl_xor(s, 32);
                if (fq == 0) unsafeAtomicAdd(ssq_out + row, s);
            }
    }
};

struct EpiIn {
    static constexpr bool PERM = true, AFTER_DRAIN = false;
    bf16_t* U; bf16_t* GLU; bf16_t* GATES; const float* bgate; const float* ssq; float invd;
    __device__ __forceinline__ void operator()(const f32x4 (&acc)[2][2][4][2], const Unit& u, int wr, int wc, int fr, int fq) const {
        const int row0 = u.pm * BM + wr * 64 + fr, cl = wc * 32 + 8 * fq;
        if (u.pn >= 12) {
            const int colb = (u.pn - 12) * BM + cl;
            f32x4 bv[2][2];
#pragma unroll
            for (int bj = 0; bj < 2; ++bj)
#pragma unroll
                for (int n = 0; n < 2; ++n) bv[bj][n] = *(const f32x4*)(bgate + colb + bj * HALF + 4 * n);
#pragma unroll
            for (int ai = 0; ai < 2; ++ai)
#pragma unroll
                for (int m = 0; m < 4; ++m) {
                    const int row = row0 + ai * HALF + m * 16;
                    const float rs = __builtin_amdgcn_rsqf(ssq[row] * invd + RMS_EPS);
#pragma unroll
                    for (int bj = 0; bj < 2; ++bj) {
                        float h[8];
#pragma unroll
                        for (int n = 0; n < 2; ++n)
#pragma unroll
                            for (int i = 0; i < 4; ++i) h[n * 4 + i] = fsigmoid(acc[ai][bj][m][n][i] * rs + bv[bj][n][i]);
                        u32x4 w; w.x = cvt_pk_bf16(h[0], h[1]); w.y = cvt_pk_bf16(h[2], h[3]); w.z = cvt_pk_bf16(h[4], h[5]); w.w = cvt_pk_bf16(h[6], h[7]);
                        *(u32x4*)(GATES + (size_t)row * 4096 + colb + bj * HALF) = w;
                    }
                }
        } else if (u.pn >= 4) {
            const int colb = (u.pn - 4) * HALF + cl;
#pragma unroll
            for (int ai = 0; ai < 2; ++ai)
#pragma unroll
                for (int m = 0; m < 4; ++m) {
                    const int row = row0 + ai * HALF + m * 16;
                    const float rs = __builtin_amdgcn_rsqf(ssq[row] * invd + RMS_EPS);
                    float h[8];
#pragma unroll
                    for (int n = 0; n < 2; ++n)
#pragma unroll
                        for (int i = 0; i < 4; ++i) h[n * 4 + i] = (acc[ai][0][m][n][i] * rs) * fsigmoid(acc[ai][1][m][n][i] * rs);
                    u32x4 w; w.x = cvt_pk_bf16(h[0], h[1]); w.y = cvt_pk_bf16(h[2], h[3]); w.z = cvt_pk_bf16(h[4], h[5]); w.w = cvt_pk_bf16(h[6], h[7]);
                    *(u32x4*)(GLU + (size_t)row * 1024 + colb) = w;
                }
        } else {
            const int colb = u.pn * BM + cl;
#pragma unroll
            for (int ai = 0; ai < 2; ++ai)
#pragma unroll
                for (int m = 0; m < 4; ++m) {
                    const int row = row0 + ai * HALF + m * 16;
                    const float rs = __builtin_amdgcn_rsqf(ssq[row] * invd + RMS_EPS);
#pragma unroll
                    for (int bj = 0; bj < 2; ++bj) {
                        const f32x4 v0 = acc[ai][bj][m][0] * rs, v1 = acc[ai][bj][m][1] * rs;
                        u32x4 w; w.x = cvt_pk_bf16(v0[0], v0[1]); w.y = cvt_pk_bf16(v0[2], v0[3]); w.z = cvt_pk_bf16(v1[0], v1[1]); w.w = cvt_pk_bf16(v1[2], v1[3]);
                        *(u32x4*)(U + (size_t)row * 1024 + colb + bj * HALF) = w;
                    }
                }
        }
    }
};

struct EpiGateA {
    static constexpr bool PERM = true, AFTER_DRAIN = false;
    bf16_t* GATES;
    __device__ __forceinline__ void operator()(const f32x4 (&acc)[2][2][4][2], const Unit& u, int wr, int wc, int fr, int fq) const {
        const int row0 = u.pm * BM + wr * 64 + fr, col0 = u.pn * BM + wc * 32 + 8 * fq;
#pragma unroll
        for (int ai = 0; ai < 2; ++ai)
#pragma unroll
            for (int m = 0; m < 4; ++m) {
                const int row = row0 + ai * HALF + m * 16;
#pragma unroll
                for (int bj = 0; bj < 2; ++bj) {
                    bf16_t* p = GATES + (size_t)row * 4096 + col0 + bj * HALF;
                    const u32x4 g = *(const u32x4*)p;
                    const f32x4 a0 = acc[ai][bj][m][0], a1 = acc[ai][bj][m][1];
                    u32x4 w; w.x = cvt_pk_bf16(bflo(g.x) * a0[0], bfhi(g.x) * a0[1]); w.y = cvt_pk_bf16(bflo(g.y) * a0[2], bfhi(g.y) * a0[3]);
                    w.z = cvt_pk_bf16(bflo(g.z) * a1[0], bfhi(g.z) * a1[1]); w.w = cvt_pk_bf16(bflo(g.w) * a1[2], bfhi(g.w) * a1[3]);
                    *(u32x4*)p = w;
                }
            }
    }
};
struct EpiGateB {
    static constexpr bool PERM = true, AFTER_DRAIN = false;
    const bf16_t* GATES; const float* bias; bf16_t* MIX;
    __device__ __forceinline__ void operator()(const f32x4 (&acc)[2][2][4][2], const Unit& u, int wr, int wc, int fr, int fq) const {
        const int row0 = u.pm * BM + wr * 64 + fr, col0 = u.pn * BM + wc * 32 + 8 * fq;
        f32x4 bv[2][2];
#pragma unroll
        for (int bj = 0; bj < 2; ++bj)
#pragma unroll
            for (int n = 0; n < 2; ++n) bv[bj][n] = *(const f32x4*)(bias + col0 + bj * HALF + 4 * n);
#pragma unroll
        for (int ai = 0; ai < 2; ++ai)
#pragma unroll
            for (int m = 0; m < 4; ++m) {
                const int row = row0 + ai * HALF + m * 16;
#pragma unroll
                for (int bj = 0; bj < 2; ++bj) {
                    const bf16_t* p = GATES + (size_t)row * 4096 + col0 + bj * HALF;
                    const u32x4 ta = *(const u32x4*)p, g = *(const u32x4*)(p + 2048);
                    const f32x4 a0 = acc[ai][bj][m][0] + bv[bj][0], a1 = acc[ai][bj][m][1] + bv[bj][1];
                    u32x4 w; w.x = cvt_pk_bf16(bflo(ta.x) + bflo(g.x) * a0[0], bfhi(ta.x) + bfhi(g.x) * a0[1]); w.y = cvt_pk_bf16(bflo(ta.y) + bflo(g.y) * a0[2], bfhi(ta.y) + bfhi(g.y) * a0[3]);
                    w.z = cvt_pk_bf16(bflo(ta.z) + bflo(g.z) * a1[0], bfhi(ta.z) + bfhi(g.z) * a1[1]); w.w = cvt_pk_bf16(bflo(ta.w) + bflo(g.w) * a1[2], bfhi(ta.w) + bfhi(g.w) * a1[3]);
                    *(u32x4*)(MIX + (size_t)row * 2048 + col0 + bj * HALF) = w;
                }
            }
    }
};
struct PairOrder {
    StaticOrder S;
    __device__ bool next(int i, Unit& u) const { if (!S.next(i >> 1, u)) return false; if (i & 1) { u.pm += S.nM; u.pn += S.nN; } return true; }
    __device__ __forceinline__ void a_ready(const Unit&) const {}
    __device__ __forceinline__ void done(const Unit&) const {}
};
struct EpiGateAB {
    static constexpr bool PERM = true, AFTER_DRAIN = false;
    EpiGateA a; EpiGateB b; int nM, nN;
    __device__ __forceinline__ void operator()(const f32x4 (&acc)[2][2][4][2], const Unit& u, int wr, int wc, int fr, int fq) const {
        if (u.pm < nM) a(acc, u, wr, wc, fr, fq);
        else { Unit v; v.pm = u.pm - nM; v.pn = u.pn - nN; b(acc, v, wr, wc, fr, fq); }
    }
};
struct EpiFinal {
    static constexpr bool PERM = true, AFTER_DRAIN = true;
    const float* base; float* out; float* ssq; unsigned* cnt; const float* gain; int ldc; float alpha, invd; unsigned ntn;
    __device__ __forceinline__ void fused(f32x4 (&acc)[2][2][4][2], const Unit& u, int wr, int wc, int fr, int fq, PG8_LAS unsigned char* lds, int wid, int lane) const {
        const int row0 = u.pm * BM + wr * 64 + fr, col0 = u.pn * BM + wc * 32 + 8 * fq;
#pragma unroll
        for (int ai = 0; ai < 2; ++ai)
#pragma unroll
            for (int m = 0; m < 4; ++m) {
                const int row = row0 + ai * HALF + m * 16; float s = 0.f;
#pragma unroll
                for (int bj = 0; bj < 2; ++bj) {
                    const size_t off = (size_t)row * ldc + col0 + bj * HALF;
                    const f32x4 b0 = *(const f32x4*)(base + off), b1 = *(const f32x4*)(base + off + 4);
                    const f32x4 v0 = b0 + acc[ai][bj][m][0] * alpha, v1 = b1 + acc[ai][bj][m][1] * alpha;
                    acc[ai][bj][m][0] = v0; acc[ai][bj][m][1] = v1;
                    s += (v0[0] * v0[0] + v0[1] * v0[1]) + (v0[2] * v0[2] + v0[3] * v0[3]) + (v1[0] * v1[0] + v1[1] * v1[1]) + (v1[2] * v1[2] + v1[3] * v1[3]);
                }
                s += __shfl_xor(s, 16); s += __shfl_xor(s, 32);
                if (fq == 0) unsafeAtomicAdd(ssq + row, s);
            }
        asm volatile("s_waitcnt vmcnt(0)" ::: "memory");
        __syncthreads();
        if (threadIdx.x == 0) {
            unsigned* c = cnt + 64 * u.pm;
            __builtin_amdgcn_fence(__ATOMIC_RELEASE, "agent");
            __hip_atomic_fetch_add(c, 1u, __ATOMIC_RELAXED, __HIP_MEMORY_SCOPE_AGENT);
            unsigned sp = 0;
            while (__hip_atomic_load(c, __ATOMIC_RELAXED, __HIP_MEMORY_SCOPE_AGENT) < ntn) { __builtin_amdgcn_s_sleep(2); if (++sp > (1u << 22)) break; }
            __builtin_amdgcn_fence(__ATOMIC_ACQUIRE, "agent");
        }
        __syncthreads();
        f32x4 gv[2][2];
#pragma unroll
        for (int bj = 0; bj < 2; ++bj)
#pragma unroll
            for (int n = 0; n < 2; ++n) gv[bj][n] = *(const f32x4*)(gain + col0 + bj * HALF + 4 * n);
#pragma unroll
        for (int ai = 0; ai < 2; ++ai)
#pragma unroll
            for (int m = 0; m < 4; ++m) {
                const int row = row0 + ai * HALF + m * 16;
                const float rs = __builtin_amdgcn_rsqf(__hip_atomic_load(ssq + row, __ATOMIC_RELAXED, __HIP_MEMORY_SCOPE_AGENT) * invd + RMS_EPS);
#pragma unroll
                for (int bj = 0; bj < 2; ++bj) {
                    const size_t off = (size_t)row * ldc + col0 + bj * HALF;
                    __builtin_nontemporal_store(acc[ai][bj][m][0] * rs * gv[bj][0], (f32x4*)(out + off));
                    __builtin_nontemporal_store(acc[ai][bj][m][1] * rs * gv[bj][1], (f32x4*)(out + off + 4));
                }
            }
    }
};
}

#ifndef MK_N_LAUNCHES
#define MK_N_LAUNCHES 1
#endif
#ifndef MK_SP2
#define MK_SP2 true
#endif
constexpr int NWAVES = 8, NTHREADS = NWAVES * 64;
constexpr int NPHASES = 11;
constexpr int BATCH = 2, T = 4096, D = 2048, M = BATCH * T, FF = 5632, DP = 1024, DC = 1024, DIN = 7168, CONVW = 31;

constexpr size_t MiB = 1u << 20;
constexpr size_t WS_CTL = 0, CTL_ZERO_BYTES = 1 * MiB;
constexpr size_t SSQ0_OFF = 65536, SSQ1_OFF = SSQ0_OFF + 32768, SSQ2_OFF = SSQ1_OFF + 32768, SSQ3_OFF = SSQ2_OFF + 32768;
constexpr size_t WS_W1T = 1 * MiB, WS_WD1T = 45 * MiB, WS_WINT = 67 * MiB, WS_WPOOLT = 95 * MiB, WS_WCONVT = 99 * MiB, WS_WOUTT = 103 * MiB, WS_W2T = 111 * MiB, WS_WD2T = 155 * MiB;
constexpr size_t WS_XB = 177 * MiB, WS_ACT = 209 * MiB, WS_GATES = 297 * MiB, WS_UGLU = 361 * MiB, WS_END = 393 * MiB;
constexpr size_t WS_U = WS_UGLU, WS_GLU = WS_UGLU + 16 * MiB, WS_P = WS_ACT + 32 * MiB, WS_Y = WS_ACT + 48 * MiB, WS_MIX = WS_ACT;
static_assert(WS_W1T + (size_t)2 * FF * D * 2 <= WS_WD1T && WS_WD1T + (size_t)D * FF * 2 <= WS_WINT && WS_WINT + (size_t)DIN * D * 2 <= WS_WPOOLT && WS_WOUTT + (size_t)D * D * 2 <= WS_W2T, "ws map");
static_assert(WS_W2T + (size_t)2 * FF * D * 2 <= WS_WD2T && WS_WD2T + (size_t)D * FF * 2 <= WS_XB && WS_XB + (size_t)M * D * 2 <= WS_ACT && WS_ACT + (size_t)M * FF * 2 <= WS_GATES && WS_GATES + (size_t)M * 4096 * 2 <= WS_END, "ws map");

constexpr int RING_BYTES = 131072, LDS_BYTES = 147456;
constexpr int MISC_OFF = LDS_BYTES - 64;
constexpr size_t CNT_OFF = 32768;
constexpr size_t GB_OFF = 53248;
constexpr size_t TRCTR_OFF = 49152;
constexpr size_t DWB_OFF = 262144;
constexpr size_t BAR_OFF = 16384;
constexpr int P0_SCR = 16640;

#define LAS __attribute__((address_space(3)))
typedef unsigned short bf16;
typedef unsigned v4u __attribute__((ext_vector_type(4)));
typedef float f32x4 __attribute__((ext_vector_type(4)));
#define LDS_WAIT() asm volatile("s_waitcnt lgkmcnt(0)" ::: "memory")
using pg8::cvt_pk_bf16; using pg8::bflo; using pg8::bfhi; using pg8::fsigmoid;

__device__ __forceinline__ float wave_sum(float v) {
#pragma unroll
    for (int o = 1; o < 64; o <<= 1) v += __shfl_xor(v, o);
    return v;
}
__device__ __forceinline__ int map_row(int mode, int n0) {
    if (mode == 0) return n0;
    if (mode == 1) return ((n0 >> 7) << 8) + (n0 & 127);
    if (mode == 2) return ((n0 >> 7) << 8) + 128 + (n0 & 127);
    if (n0 < 1024 || n0 >= 3072) return n0;
    if (n0 < 2048) { const int j = n0 - 1024; return 1024 + ((j >> 7) << 8) + (j & 127); }
    const int j = n0 - 2048; return 1024 + ((j >> 7) << 8) + 128 + (j & 127);
}
__device__ __forceinline__ void p0_tr_item(const float* __restrict__ W, int K, int N, const float* __restrict__ gain, bf16* __restrict__ WT, int mode, int item, int lane) {
    const int nblk = N >> 7, kb = item / nblk, nb = item - kb * nblk, k0 = (kb << 6) + ((lane >> 5) << 5), n0 = (nb << 7) + ((lane & 31) << 2);
    const float* src = W + (size_t)k0 * N + n0;
    f32x4 v[32];
#pragma unroll
    for (int i = 0; i < 32; ++i) v[i] = __builtin_nontemporal_load((const f32x4*)(src + (size_t)i * N));
    if (gain) {
#pragma unroll
        for (int i = 0; i < 32; ++i) v[i] *= gain[k0 + i];
    }
    bf16* dst = WT + (size_t)map_row(mode, n0) * K + k0;
#pragma unroll
    for (int j = 0; j < 4; ++j)
#pragma unroll
        for (int q = 0; q < 4; ++q) {
            v4u o; o.x = cvt_pk_bf16(v[8 * q + 0][j], v[8 * q + 1][j]); o.y = cvt_pk_bf16(v[8 * q + 2][j], v[8 * q + 3][j]); o.z = cvt_pk_bf16(v[8 * q + 4][j], v[8 * q + 5][j]); o.w = cvt_pk_bf16(v[8 * q + 6][j], v[8 * q + 7][j]);
            *(v4u*)(dst + (size_t)j * K + 8 * q) = o;
        }
}
__device__ __forceinline__ void p0_fold_item(const float* __restrict__ wg, const float* __restrict__ scale, const float* __restrict__ wp, bf16* __restrict__ WPT, int item, LAS float* scr, int lane) {
    const int nb = item & 31, cb = (item >> 5) & 15, g = item >> 9, n0 = nb << 6, c0 = cb << 4;
#pragma unroll
    for (int ci = 0; ci < 16; ++ci) {
        const f32x4 a = *(const f32x4*)(wg + ((size_t)(g * 256 + c0 + ci)) * 256 + lane * 4), s = *(const f32x4*)(scale + g * 256 + lane * 4);
        *(LAS f32x4*)(scr + ci * 256 + lane * 4) = a * s;
    }
    LDS_WAIT(); asm volatile("" ::: "memory");
    float acc[16];
#pragma unroll
    for (int ci = 0; ci < 16; ++ci) acc[ci] = 0.f;
    const float* bp = wp + (size_t)(g * 256) * D + n0 + lane;
    for (int d = 0; d < 256; d += 4) {
        const float b0 = bp[(size_t)(d + 0) * D], b1 = bp[(size_t)(d + 1) * D], b2 = bp[(size_t)(d + 2) * D], b3 = bp[(size_t)(d + 3) * D];
#pragma unroll
        for (int ci = 0; ci < 16; ++ci) { const f32x4 a = *(const LAS f32x4*)(scr + ci * 256 + d); acc[ci] += (a[0] * b0 + a[1] * b1) + (a[2] * b2 + a[3] * b3); }
    }
    v4u o0, o1;
    o0.x = cvt_pk_bf16(acc[0], acc[1]); o0.y = cvt_pk_bf16(acc[2], acc[3]); o0.z = cvt_pk_bf16(acc[4], acc[5]); o0.w = cvt_pk_bf16(acc[6], acc[7]);
    o1.x = cvt_pk_bf16(acc[8], acc[9]); o1.y = cvt_pk_bf16(acc[10], acc[11]); o1.z = cvt_pk_bf16(acc[12], acc[13]); o1.w = cvt_pk_bf16(acc[14], acc[15]);
    bf16* dst = WPT + (size_t)(n0 + lane) * DP + g * 256 + c0;
    *(v4u*)dst = o0; *(v4u*)(dst + 8) = o1;
    LDS_WAIT(); asm volatile("" ::: "memory");
}
__device__ __forceinline__ void unpack8(const v4u w, float (&f)[8]) { f[0] = bflo(w.x); f[1] = bfhi(w.x); f[2] = bflo(w.y); f[3] = bfhi(w.y); f[4] = bflo(w.z); f[5] = bfhi(w.z); f[6] = bflo(w.w); f[7] = bfhi(w.w); }
__device__ __forceinline__ v4u pack8(const float (&f)[8]) { v4u o; o.x = cvt_pk_bf16(f[0], f[1]); o.y = cvt_pk_bf16(f[2], f[3]); o.z = cvt_pk_bf16(f[4], f[5]); o.w = cvt_pk_bf16(f[6], f[7]); return o; }

template <int HMAX>
__device__ __forceinline__ void p4_pool_half(const bf16* __restrict__ ucol, bf16* __restrict__ pcol, int t0, int h) {
    float s[4][8], u[4][8];
#pragma unroll
    for (int r = 0; r < 4; ++r)
#pragma unroll
        for (int i = 0; i < 8; ++i) s[r][i] = 0.f;
#pragma unroll
    for (int jd = -HMAX; jd < 3 + HMAX; ++jd) {
        const int tt = t0 + jd, ttc = tt < 0 ? 0 : (tt >= T ? T - 1 : tt);
        const unsigned msk = (tt == ttc) ? 0xffffffffu : 0u;
        v4u w = *(const v4u*)(ucol + (size_t)ttc * DP);
        w.x &= msk; w.y &= msk; w.z &= msk; w.w &= msk;
        float f[8]; unpack8(w, f);
#pragma unroll
        for (int r = 0; r < 4; ++r) {
            const int rel = jd - r;
            if (rel >= -HMAX && rel < HMAX) {
                const float mk = (rel >= -h && rel < h) ? 1.f : 0.f;
#pragma unroll
                for (int i = 0; i < 8; ++i) s[r][i] += f[i] * mk;
            }
            if (rel == 0) {
#pragma unroll
                for (int i = 0; i < 8; ++i) u[r][i] = f[i];
            }
        }
    }
#pragma unroll
    for (int r = 0; r < 4; ++r) {
        const int t = t0 + r, lo = t - h < 0 ? 0 : t - h, hi = t + h > T ? T : t + h;
        const float inv = 1.0f / (float)(hi - lo);
        float o[8];
#pragma unroll
        for (int i = 0; i < 8; ++i) o[i] = s[r][i] * inv - u[r][i];
        *(v4u*)(pcol + (size_t)t * DP) = pack8(o);
    }
}
__device__ __forceinline__ void p4_pool_item(const bf16* __restrict__ U, bf16* __restrict__ P, int item, int lane) {
    const int r0 = item * 4, b = r0 / T, t0 = r0 - b * T;
    const bf16* ub = U + (size_t)(b * T) * DP; bf16* pb = P + (size_t)(b * T) * DP;
    p4_pool_half<2>(ub + lane * 8, pb + lane * 8, t0, 1 << (lane >> 5));
    p4_pool_half<8>(ub + 512 + lane * 8, pb + 512 + lane * 8, t0, 4 << (lane >> 5));
}
__device__ __forceinline__ const char* uniform_ptr(const void* p) {
    const unsigned long long v = (unsigned long long)p;
    const unsigned lo = __builtin_amdgcn_readfirstlane((unsigned)v), hi = __builtin_amdgcn_readfirstlane((unsigned)(v >> 32));
    return (const char*)(((unsigned long long)hi << 32) | lo);
}
constexpr int CONV_GS = 12, CONV_NG = (CONVW + 3 + CONV_GS) / CONV_GS;
struct ConvGrp { v4u g[CONV_GS], w[CONV_GS]; };
__device__ __forceinline__ void p4_conv_load(ConvGrp& G, const bf16* __restrict__ gbase, const bf16* __restrict__ wbase, int coff, int t0, int jj) {
#pragma unroll
    for (int u = 0; u < CONV_GS; ++u) {
        const int j = jj * CONV_GS + u, jc = j < CONVW ? j : CONVW - 1;
        G.w[u] = *(const v4u*)(uniform_ptr(wbase + jc * DC) + (unsigned)coff * 2u);
        const int t = t0 - 15 + j, tc = t < 0 ? 0 : (t >= T ? T - 1 : t);
        G.g[u] = *(const v4u*)(uniform_ptr(gbase + (size_t)tc * DC) + (unsigned)coff * 2u);
    }
}
__device__ __forceinline__ void p4_conv_half(const bf16* __restrict__ gbase, const bf16* __restrict__ wbase, int coff, int t0, float (&acc)[4][8]) {
    float w[4][8];
#pragma unroll
    for (int u = 0; u < 4; ++u)
#pragma unroll
        for (int i = 0; i < 8; ++i) w[u][i] = 0.f;
#pragma unroll 1
    for (int jj = 0; jj < CONV_NG; ++jj) {
        ConvGrp cur;
        p4_conv_load(cur, gbase, wbase, coff, t0, jj);
#pragma unroll
        for (int u = 0; u < CONV_GS; ++u) {
            const int j = jj * CONV_GS + u, t = t0 - 15 + j;
            const float wm = j < CONVW ? 1.f : 0.f;
            const unsigned msk = (t >= 0 && t < T) ? 0xffffffffu : 0u;
            { float wf[8]; unpack8(cur.w[u], wf);
#pragma unroll
              for (int i = 0; i < 8; ++i) w[u & 3][i] = wf[i] * wm; }
            v4u ga = cur.g[u]; ga.x &= msk; ga.y &= msk; ga.z &= msk; ga.w &= msk;
            float g[8]; unpack8(ga, g);
#pragma unroll
            for (int r = 0; r < 4; ++r)
#pragma unroll
                for (int i = 0; i < 8; ++i) acc[r][i] += w[(u - r) & 3][i] * g[i];
        }
    }
}
__device__ __forceinline__ void p4_conv_item(const bf16* __restrict__ GLU, const bf16* __restrict__ dww, const float* __restrict__ dwb, const float* __restrict__ lng, const float* __restrict__ lnb,
                                             bf16* __restrict__ Y, int item, int lane) {
    const int r0 = item * 4, b = r0 / T, t0 = r0 - b * T;
    const int cA = lane * 8, cB = 512 + lane * 8;
    const bf16* gb = GLU + (size_t)(b * T) * DC;
    float accA[4][8], accB[4][8];
    asm volatile("" ::: "memory");
    {
        const f32x4 b0 = *(const f32x4*)(dwb + cA), b1 = *(const f32x4*)(dwb + cA + 4), b2 = *(const f32x4*)(dwb + cB), b3 = *(const f32x4*)(dwb + cB + 4);
#pragma unroll
        for (int r = 0; r < 4; ++r)
#pragma unroll
            for (int i = 0; i < 4; ++i) { accA[r][i] = b0[i]; accA[r][4 + i] = b1[i]; accB[r][i] = b2[i]; accB[r][4 + i] = b3[i]; }
    }
    p4_conv_half(gb, dww, cA, t0, accA);
    __builtin_amdgcn_sched_barrier(0);
    p4_conv_half(gb, dww, cB, t0, accB);
    f32x4 lg[4], lb[4];
    asm volatile("" ::: "memory");
    lg[0] = *(const f32x4*)(lng + cA); lg[1] = *(const f32x4*)(lng + cA + 4); lg[2] = *(const f32x4*)(lng + cB); lg[3] = *(const f32x4*)(lng + cB + 4);
    lb[0] = *(const f32x4*)(lnb + cA); lb[1] = *(const f32x4*)(lnb + cA + 4); lb[2] = *(const f32x4*)(lnb + cB); lb[3] = *(const f32x4*)(lnb + cB + 4);
#pragma unroll
    for (int r = 0; r < 4; ++r) {
        float s = 0.f;
#pragma unroll
        for (int i = 0; i < 8; ++i) s += accA[r][i] + accB[r][i];
        const float mu = wave_sum(s) * (1.0f / DC);
        float q = 0.f;
#pragma unroll
        for (int i = 0; i < 8; ++i) { accA[r][i] -= mu; accB[r][i] -= mu; q += accA[r][i] * accA[r][i] + accB[r][i] * accB[r][i]; }
        const float rstd = __builtin_amdgcn_rsqf(wave_sum(q) * (1.0f / DC) + pg8::RMS_EPS);
        float oa[8], ob[8];
#pragma unroll
        for (int i = 0; i < 8; ++i) {
            const float ya = accA[r][i] * rstd * lg[i >> 2][i & 3] + lb[i >> 2][i & 3], yb = accB[r][i] * rstd * lg[2 + (i >> 2)][i & 3] + lb[2 + (i >> 2)][i & 3];
            oa[i] = ya * fsigmoid(ya); ob[i] = yb * fsigmoid(yb);
        }
        bf16* yr = Y + (size_t)(r0 + r) * DC;
        *(v4u*)(yr + cA) = pack8(oa); *(v4u*)(yr + cB) = pack8(ob);
    }
}

#define RLX_AGENT __ATOMIC_RELAXED, __HIP_MEMORY_SCOPE_AGENT
#define XB_TMO      128
#define XB_XCNT(j)  (256  + 64 * (j))
#define XB_XSUB(j)  (1280 + 64 * (j))
#define XB_XGEN(j)  (2304 + 64 * (j))
#define XB_TOP      3328
#define XB_TOPGEN   3392
#define XCD_BAR_WORDS 3456
#define XB_SPIN_CAP (1u << 18)

__device__ __forceinline__ unsigned xb_ld(unsigned* p)              { return __hip_atomic_load(p, __ATOMIC_RELAXED, __HIP_MEMORY_SCOPE_AGENT); }
__device__ __forceinline__ unsigned xb_add(unsigned* p, unsigned v) { return __hip_atomic_fetch_add(p, v, __ATOMIC_RELAXED, __HIP_MEMORY_SCOPE_AGENT); }
__device__ __forceinline__ unsigned xb_xcc_id() { return (unsigned)__builtin_amdgcn_s_getreg((3 << 11) | 20) & 0xFu; }
#define XB_SPIN(cond, bar) do { unsigned _sp = 0; while (cond) { __builtin_amdgcn_s_sleep(1); \
    if ((++_sp & 255u) == 0u) { if (xb_ld(&(bar)[XB_TMO])) break; if (_sp > XB_SPIN_CAP) { atomicAdd(&(bar)[XB_TMO], 1u); break; } } } } while (0)

struct XcdBarrier {
    unsigned* bar; unsigned x;
    volatile LAS unsigned* st;
};

__device__ __forceinline__ XcdBarrier xcd_barrier_post(unsigned* bar, volatile LAS unsigned* st) {
    XcdBarrier b; b.bar = bar; b.x = xb_xcc_id(); b.st = st;
    if (threadIdx.x == 0) (void)xb_add(&bar[XB_XCNT(b.x)], 1u);
    return b;
}
__device__ __forceinline__ void xcd_barrier_complete(unsigned* bar, unsigned x, unsigned& nloc, unsigned& nx) {
    const unsigned G = gridDim.x * gridDim.y * gridDim.z;
    unsigned sum, cnt, mine, sp = 0u;
    for (;;) {
        sum = 0u; cnt = 0u; mine = 0u;
#pragma unroll
        for (unsigned j = 0; j < 16; ++j) { const unsigned c = xb_ld(&bar[XB_XCNT(j)]); sum += c; cnt += (c > 0u) ? 1u : 0u; mine = (j == x) ? c : mine; }
        if (sum == G) break;
        __builtin_amdgcn_s_sleep(1);
        if ((++sp & 255u) == 0u) { if (xb_ld(&bar[XB_TMO])) break; if (sp > XB_SPIN_CAP) { atomicAdd(&bar[XB_TMO], 1u); break; } }
    }
    nloc = mine > 0u ? mine : 1u; nx = cnt > 0u ? cnt : 1u;
}

__device__ __forceinline__ void xcd_barrier(const XcdBarrier& b) {
    asm volatile("s_waitcnt vmcnt(0)" ::: "memory");
    __syncthreads();
    if (threadIdx.x == 0) {
        unsigned* bar = b.bar;
        __builtin_amdgcn_s_waitcnt(0);
        unsigned nloc = b.st[0], nx = b.st[1];
        if (nloc == 0u) { xcd_barrier_complete(bar, b.x, nloc, nx); b.st[0] = nloc; b.st[1] = nx; }
        const unsigned old = xb_add(&bar[XB_XSUB(b.x)], 1u);
        const unsigned gen = old / nloc;
        if (old + 1u == (gen + 1u) * nloc) {
            __builtin_amdgcn_fence(__ATOMIC_RELEASE, "agent");
            asm volatile("s_waitcnt vmcnt(0)" ::: "memory");
            const unsigned og = xb_add(&bar[XB_TOP], 1u);
            const unsigned tg = og / nx;
            if (og + 1u == (tg + 1u) * nx) xb_add(&bar[XB_TOPGEN], 1u);
            else XB_SPIN(xb_ld(&bar[XB_TOPGEN]) == tg, bar);
            __builtin_amdgcn_fence(__ATOMIC_ACQUIRE, "agent");
            xb_add(&bar[XB_XGEN(b.x)], 1u);
            asm volatile("s_waitcnt vmcnt(0)" ::: "memory");
        } else {
            XB_SPIN(xb_ld(&bar[XB_XGEN(b.x)]) == gen, bar);
            __builtin_amdgcn_fence(__ATOMIC_ACQUIRE, "agent");
            asm volatile("s_waitcnt vmcnt(0)" ::: "memory");
        }
    }
    __syncthreads();
}

__device__ __forceinline__ void group_barrier(unsigned* ctr, unsigned target, unsigned use, bool same_xcd) {
    asm volatile("s_waitcnt vmcnt(0)" ::: "memory");
    __syncthreads();
    if (threadIdx.x == 0) {
        if (!same_xcd) { __builtin_amdgcn_fence(__ATOMIC_RELEASE, "agent"); asm volatile("s_waitcnt vmcnt(0)" ::: "memory"); }
        const unsigned old = __hip_atomic_fetch_add(ctr, 1u, __ATOMIC_RELAXED, __HIP_MEMORY_SCOPE_AGENT);
        if (old + 1u == target) {
            __hip_atomic_fetch_add(ctr + 1, 1u, __ATOMIC_RELAXED, __HIP_MEMORY_SCOPE_AGENT);
        } else {
            unsigned sp = 0;
            while (__hip_atomic_load(ctr + 1, __ATOMIC_RELAXED, __HIP_MEMORY_SCOPE_AGENT) < use) { __builtin_amdgcn_s_sleep(1); if (++sp > (1u << 22)) break; }
        }
        __builtin_amdgcn_fence(__ATOMIC_ACQUIRE, "agent");
        asm volatile("s_waitcnt vmcnt(0)" ::: "memory");
    }
    __syncthreads();
}
struct Args { const float* in[23]; float* out; unsigned char* ws; int ph_lo, ph_hi; };

constexpr int I_GU = (D / 64) * (FF / 128), I_DN = (FF / 64) * (D / 128), I_IN = (D / 64) * (DIN / 128), I_CV = (DC / 64) * (D / 128), I_WO = (D / 64) * (D / 128), I_FOLD = 4 * 16 * 32;
constexpr int TR_W1U = I_GU, TR_WD1 = 2 * I_GU, TR_WIN = TR_WD1 + I_DN, TR_CV = TR_WIN + I_IN, TR_WO = TR_CV + I_CV, TR_W2G = TR_WO + I_WO, TR_W2U = TR_W2G + I_GU, TR_WD2 = TR_W2U + I_GU, TR_END = TR_WD2 + I_DN;
#ifndef MK_TR_C0
#define MK_TR_C0 TR_WD1
#endif
#ifndef MK_TR_C1
#define MK_TR_C1 TR_W2G
#endif
#ifndef MK_TR_C2
#define MK_TR_C2 TR_WD2
#endif
constexpr int TR_C0 = MK_TR_C0, TR_C1 = MK_TR_C1, TR_C2 = MK_TR_C2;
static_assert(TR_C0 >= TR_WD1 && TR_C1 >= TR_CV && TR_C1 >= TR_C0 && TR_C2 >= TR_C1, "conversion segments follow the phases' dependencies");
__device__ __forceinline__ void tr_run(const Args& args, int lo, int hi, int worker, int nworkers, int lane) {
    unsigned char* ws = args.ws;
    for (int g = lo + worker; g < hi; g += nworkers) {
        if (g < TR_W1U)      p0_tr_item(args.in[2],  D,  FF,  args.in[1],  (bf16*)(ws + WS_W1T),    1, g,          lane);
        else if (g < TR_WD1) p0_tr_item(args.in[3],  D,  FF,  args.in[1],  (bf16*)(ws + WS_W1T),    2, g - TR_W1U, lane);
        else if (g < TR_WIN) p0_tr_item(args.in[4],  FF, D,   nullptr,     (bf16*)(ws + WS_WD1T),   0, g - TR_WD1, lane);
        else if (g < TR_CV)  p0_tr_item(args.in[6],  D,  DIN, args.in[5],  (bf16*)(ws + WS_WINT),   3, g - TR_WIN, lane);
        else if (g < TR_WO)  p0_tr_item(args.in[15], DC, D,   nullptr,     (bf16*)(ws + WS_WCONVT), 0, g - TR_CV,  lane);
        else if (g < TR_W2G) p0_tr_item(args.in[17], D,  D,   nullptr,     (bf16*)(ws + WS_WOUTT),  0, g - TR_WO,  lane);
        else if (g < TR_W2U) p0_tr_item(args.in[19], D,  FF,  args.in[18], (bf16*)(ws + WS_W2T),    1, g - TR_W2G, lane);
        else if (g < TR_WD2) p0_tr_item(args.in[20], D,  FF,  args.in[18], (bf16*)(ws + WS_W2T),    2, g - TR_W2U, lane);
        else                 p0_tr_item(args.in[21], FF, D,   nullptr,     (bf16*)(ws + WS_WD2T),   0, g - TR_WD2, lane);
    }
}
__device__ __forceinline__ void tr_run_dyn(const Args& args, int lo, int hi, unsigned* ctr, int lane) {
    unsigned char* ws = args.ws;
    for (;;) {
        int g = 0;
        if (lane == 0) g = lo + (int)__hip_atomic_fetch_add(ctr, 1u, __ATOMIC_RELAXED, __HIP_MEMORY_SCOPE_AGENT);
        g = __builtin_amdgcn_readfirstlane(g);
        if (g >= hi) break;
        if (g < TR_W1U)      p0_tr_item(args.in[2],  D,  FF,  args.in[1],  (bf16*)(ws + WS_W1T),    1, g,          lane);
        else if (g < TR_WD1) p0_tr_item(args.in[3],  D,  FF,  args.in[1],  (bf16*)(ws + WS_W1T),    2, g - TR_W1U, lane);
        else if (g < TR_WIN) p0_tr_item(args.in[4],  FF, D,   nullptr,     (bf16*)(ws + WS_WD1T),   0, g - TR_WD1, lane);
        else if (g < TR_CV)  p0_tr_item(args.in[6],  D,  DIN, args.in[5],  (bf16*)(ws + WS_WINT),   3, g - TR_WIN, lane);
        else if (g < TR_WO)  p0_tr_item(args.in[15], DC, D,   nullptr,     (bf16*)(ws + WS_WCONVT), 0, g - TR_CV,  lane);
        else if (g < TR_W2G) p0_tr_item(args.in[17], D,  D,   nullptr,     (bf16*)(ws + WS_WOUTT),  0, g - TR_WO,  lane);
        else if (g < TR_W2U) p0_tr_item(args.in[19], D,  FF,  args.in[18], (bf16*)(ws + WS_W2T),    1, g - TR_W2G, lane);
        else if (g < TR_WD2) p0_tr_item(args.in[20], D,  FF,  args.in[18], (bf16*)(ws + WS_W2T),    2, g - TR_W2U, lane);
        else                 p0_tr_item(args.in[21], FF, D,   nullptr,     (bf16*)(ws + WS_WD2T),   0, g - TR_WD2, lane);
    }
}
__device__ __forceinline__ bool tail_worker(int ntiles, int G, int bid, int wave, int& worker, int& nworkers) {
    const int rounds = (ntiles + G - 1) / G, last = ntiles - (rounds - 1) * G;
    if (last == G) { worker = bid * NWAVES + wave; nworkers = G * NWAVES; return true; }
    if (bid < last) return false;
    worker = (bid - last) * NWAVES + wave; nworkers = (G - last) * NWAVES; return true;
}

__global__ void __launch_bounds__(NTHREADS, 2) mk_fwd(Args args) {
    extern __shared__ __attribute__((aligned(16))) unsigned char lds_raw[];
    LAS unsigned char* lds = (LAS unsigned char*)lds_raw;
    cg::grid_group grid = cg::this_grid();
    const int tid = threadIdx.x, lane = tid & 63, wave = __builtin_amdgcn_readfirstlane(tid >> 6);
    const int G = gridDim.x, gw = blockIdx.x * NWAVES + wave, NGW = G * NWAVES;
    unsigned char* ws = args.ws;
    const float* x = args.in[0];
    float* out = args.out;
    float* ssq0 = (float*)(ws + SSQ0_OFF); float* ssq1 = (float*)(ws + SSQ1_OFF); float* ssq2 = (float*)(ws + SSQ2_OFF); float* ssq3 = (float*)(ws + SSQ3_OFF);
    bf16* W1T = (bf16*)(ws + WS_W1T); bf16* WD1T = (bf16*)(ws + WS_WD1T); bf16* WINT = (bf16*)(ws + WS_WINT); bf16* WPOOLT = (bf16*)(ws + WS_WPOOLT); bf16* WCONVT = (bf16*)(ws + WS_WCONVT);
    bf16* WOUTT = (bf16*)(ws + WS_WOUTT); bf16* W2T = (bf16*)(ws + WS_W2T); bf16* WD2T = (bf16*)(ws + WS_WD2T);
    bf16* XB = (bf16*)(ws + WS_XB); bf16* ACT = (bf16*)(ws + WS_ACT); bf16* GATES = (bf16*)(ws + WS_GATES);
    bf16* UB = (bf16*)(ws + WS_U); bf16* GLUB = (bf16*)(ws + WS_GLU); bf16* PB = (bf16*)(ws + WS_P); bf16* YB = (bf16*)(ws + WS_Y); bf16* MIX = (bf16*)(ws + WS_MIX);
    const int lo = args.ph_lo, hi = args.ph_hi;
    if (lo < 0) grid.sync();
    volatile LAS unsigned* MISC = (volatile LAS unsigned*)(lds + MISC_OFF);
    if (tid < 16) MISC[tid] = 0u;
    __syncthreads();
    XcdBarrier bar = xcd_barrier_post((unsigned*)(ws + BAR_OFF), MISC + 8);
#ifndef MK_PHM
#define MK_PHM 0xffffu
#endif
#define IN(k) (((MK_PHM >> (k)) & 1u) && lo <= (k) && (k) < hi)
#ifndef MK_REP
#define MK_REP 0u
#endif
#define REPS(k) (1 + (int)((MK_REP >> (k)) & 1u))
#define SEAM(k) do { if (IN(k) && IN((k) + 1)) xcd_barrier(bar); } while (0)
    const bool use_gb = (G % 8 == 0);
    const int grp = (int)blockIdx.x & 7, gsize = G >> 3; unsigned gb_use = 0;
    unsigned* gb_ctr = (unsigned*)(ws + GB_OFF) + 64 * grp;
    if (tid == 0) { const unsigned xc = xb_xcc_id(); __hip_atomic_fetch_max(gb_ctr + 2, xc + 1u, __ATOMIC_RELAXED, __HIP_MEMORY_SCOPE_AGENT); __hip_atomic_fetch_max(gb_ctr + 3, 16u - xc, __ATOMIC_RELAXED, __HIP_MEMORY_SCOPE_AGENT); }
    bool gb_same = false;
#define GSEAM(k) do { if (IN(k) && IN((k) + 1)) { if (use_gb) { ++gb_use; group_barrier(gb_ctr, gb_use * (unsigned)gsize, gb_use, gb_same); } else xcd_barrier(bar); } } while (0)
    constexpr float INVD = 1.0f / D;

    if (IN(0)) {
        LAS float* scr = (LAS float*)(lds + wave * P0_SCR);
        tr_run(args, 0, TR_C0, gw, NGW, lane);
        for (int it = gw; it < I_FOLD; it += NGW) p0_fold_item(args.in[8], args.in[9], args.in[10], WPOOLT, it, scr, lane);
        for (int i = gw * 64 + lane; i < CONVW * DC / 2; i += NGW * 64) ((unsigned*)(ws + DWB_OFF))[i] = cvt_pk_bf16(args.in[11][2 * i], args.in[11][2 * i + 1]);
        for (int m = gw; m < M; m += NGW) {
            const f32x4* xr = (const f32x4*)(x + (size_t)m * D); float s = 0.f;
#pragma unroll
            for (int j = 0; j < 4; ++j) {
                const f32x4 a = __builtin_nontemporal_load(xr + j * 128 + lane * 2), b = __builtin_nontemporal_load(xr + j * 128 + lane * 2 + 1);
                s += (a[0] * a[0] + a[1] * a[1]) + (a[2] * a[2] + a[3] * a[3]) + (b[0] * b[0] + b[1] * b[1]) + (b[2] * b[2] + b[3] * b[3]);
                v4u o; o.x = cvt_pk_bf16(a[0], a[1]); o.y = cvt_pk_bf16(a[2], a[3]); o.z = cvt_pk_bf16(b[0], b[1]); o.w = cvt_pk_bf16(b[2], b[3]);
                *(v4u*)(XB + (size_t)m * D + j * 512 + lane * 8) = o;
            }
            s = wave_sum(s);
            if (lane == 0) ssq0[m] = s;
        }
        __syncthreads();
    }
    SEAM(0);
    if (IN(0) && IN(1)) gb_same = (__hip_atomic_load(gb_ctr + 2, __ATOMIC_RELAXED, __HIP_MEMORY_SCOPE_AGENT) - 1u) == (16u - __hip_atomic_load(gb_ctr + 3, __ATOMIC_RELAXED, __HIP_MEMORY_SCOPE_AGENT));
    if (IN(1)) {
        pg8::Gemm g{XB, W1T, M, 2 * FF, D}; pg8::StaticOrder S; S.init(M, 2 * FF, G, (int)blockIdx.x);
        pg8::EpiSwiglu E{ACT, FF, ssq0, INVD};
        pg8::gemm_phase<pg8::EpiSwiglu, pg8::StaticOrder, true, MK_SP2>(lds, g, S, E);
        { int worker, nworkers; if (tail_worker((M / 256) * (2 * FF / 256), G, (int)blockIdx.x, wave, worker, nworkers)) tr_run(args, TR_C0, TR_C1, worker, nworkers, lane); }
    }
    SEAM(1);
    if (IN(2)) {
        pg8::Gemm g{ACT, WD1T, M, D, FF}; pg8::StaticOrder S; S.init(M, D, G, (int)blockIdx.x);
        pg8::EpiResid E{x, out, XB, ssq1, D, 0.5f};
        pg8::gemm_phase<pg8::EpiResid, pg8::StaticOrder, true, MK_SP2>(lds, g, S, E);
    }
    GSEAM(2);
    if (IN(3)) {
        pg8::Gemm g{XB, WINT, M, DIN, D}; pg8::StaticOrder S; S.init(M, DIN, G, (int)blockIdx.x);
        pg8::EpiIn E{UB, GLUB, GATES, args.in[7], ssq1, INVD};
        pg8::gemm_phase<pg8::EpiIn, pg8::StaticOrder, true, MK_SP2>(lds, g, S, E);
        { int worker, nworkers; if (tail_worker((M / 256) * (DIN / 256), G, (int)blockIdx.x, wave, worker, nworkers)) tr_run(args, TR_C1, TR_C2, worker, nworkers, lane); }
    }
    SEAM(3);
    if (IN(4)) {
#ifndef NO_CONV
        const int p4_first = use_gb ? ((int)blockIdx.x >> 3) * NWAVES + wave : gw, p4_step = use_gb ? gsize * NWAVES : NGW, p4_n = use_gb ? M / 32 : M / 4, p4_base = use_gb ? grp * (M / 32) : 0;
        for (int il = p4_first; il < p4_n; il += p4_step) p4_conv_item(GLUB, (const bf16*)(ws + DWB_OFF), args.in[12], args.in[13], args.in[14], YB, p4_base + il, lane);
#endif
#ifndef NO_POOL
        for (int il = p4_first; il < p4_n; il += p4_step) p4_pool_item(UB, PB, p4_base + il, lane);
#endif
        __syncthreads();
    }
    GSEAM(4);
    static_assert(WS_Y == WS_P + (size_t)M * DP * 2 && WS_WCONVT == WS_WPOOLT + (size_t)D * DP * 2 && DP == DC, "P | Y and Wpool_t | Wconv_t are adjacent: the conv unit is a row offset into both operands");
    if (IN(5) && IN(6)) {
        pg8::Gemm g{PB, WPOOLT, 2 * M, 2 * D, DP}; pg8::PairOrder S; S.S.init(M, D, G, (int)blockIdx.x);
        pg8::EpiGateAB E{pg8::EpiGateA{GATES}, pg8::EpiGateB{GATES, args.in[16], MIX}, M / 256, D / 256};
        pg8::gemm_phase<pg8::EpiGateAB, pg8::PairOrder, true, MK_SP2>(lds, g, S, E);
    }
    GSEAM(6);
    if (IN(7)) {
        pg8::Gemm g{MIX, WOUTT, M, D, D}; pg8::StaticOrder S; S.init(M, D, G, (int)blockIdx.x);
        pg8::EpiResid E{out, out, XB, ssq2, D, 1.0f};
        pg8::gemm_phase<pg8::EpiResid, pg8::StaticOrder, true, MK_SP2>(lds, g, S, E);
    }
    SEAM(7);
    if (IN(8)) {
        pg8::Gemm g{XB, W2T, M, 2 * FF, D}; pg8::StaticOrder S; S.init(M, 2 * FF, G, (int)blockIdx.x);
        pg8::EpiSwiglu E{ACT, FF, ssq2, INVD};
        pg8::gemm_phase<pg8::EpiSwiglu, pg8::StaticOrder, true, MK_SP2>(lds, g, S, E);
        { int worker, nworkers; if (tail_worker((M / 256) * (2 * FF / 256), G, (int)blockIdx.x, wave, worker, nworkers)) tr_run(args, TR_C2, TR_END, worker, nworkers, lane); }
    }
    SEAM(8);
    const bool fuse_final = (G == (M / 256) * (D / 256)) && IN(9) && IN(10);
    if (IN(9)) {
        pg8::Gemm g{ACT, WD2T, M, D, FF}; pg8::StaticOrder S; S.init(M, D, G, (int)blockIdx.x);
        if (fuse_final) {
            pg8::EpiFinal E{out, out, ssq3, (unsigned*)(ws + CNT_OFF), args.in[22], D, 0.5f, INVD, (unsigned)(D / 256)};
            pg8::gemm_phase<pg8::EpiFinal, pg8::StaticOrder, false, MK_SP2>(lds, g, S, E);
        } else {
            pg8::EpiResid E{out, out, nullptr, ssq3, D, 0.5f};
            pg8::gemm_phase<pg8::EpiResid, pg8::StaticOrder, true, MK_SP2>(lds, g, S, E);
        }
    }
    if (!fuse_final) SEAM(9);
    if (IN(10) && !fuse_final) {
        const f32x4* gn = (const f32x4*)args.in[22];
        for (int m = gw; m < M; m += NGW) {
            const float rs = __builtin_amdgcn_rsqf(ssq3[m] * INVD + pg8::RMS_EPS);
            f32x4* xr = (f32x4*)(out + (size_t)m * D);
#pragma unroll
            for (int j = 0; j < 8; ++j) { const f32x4 v = __builtin_nontemporal_load(xr + j * 64 + lane); __builtin_nontemporal_store(v * rs * gn[j * 64 + lane], xr + j * 64 + lane); }
        }
    }
#undef IN
#undef SEAM
}

extern "C" void kernel_launch(void* const* d_in, const int* in_sizes, int n_in, void* d_out, int out_size, void* d_ws, size_t ws_size, hipStream_t stream) {
    static int grid = 0;
    if (grid == 0) {
        if (n_in != 23 || in_sizes[0] != M * D || out_size != M * D || ws_size < WS_END) { fprintf(stderr, "kernel_launch: unexpected shapes / workspace (n_in %d, ws %zu, need %zu)\n", n_in, ws_size, (size_t)WS_END); grid = -1; return; }
        int dev = 0, cus = 0, per_cu = 0;
        if (hipGetDevice(&dev) != hipSuccess || hipDeviceGetAttribute(&cus, hipDeviceAttributeMultiprocessorCount, dev) != hipSuccess) { grid = -1; return; }
        if (hipFuncSetAttribute((const void*)mk_fwd, hipFuncAttributeMaxDynamicSharedMemorySize, LDS_BYTES) != hipSuccess) { fprintf(stderr, "kernel_launch: hipFuncSetAttribute failed\n"); grid = -1; return; }
        if (hipOccupancyMaxActiveBlocksPerMultiprocessor(&per_cu, (const void*)mk_fwd, NTHREADS, LDS_BYTES) != hipSuccess || per_cu < 1) { fprintf(stderr, "kernel_launch: occupancy query reports %d blocks per CU\n", per_cu); (void)hipGetLastError(); grid = -1; return; }
        grid = cus;
    }
    if (grid < 0) return;
    (void)hipMemsetAsync((char*)d_ws + WS_CTL, 0, CTL_ZERO_BYTES, stream);
    Args a{};
    for (int i = 0; i < 23; ++i) a.in[i] = (const float*)d_in[i];
    a.out = (float*)d_out; a.ws = (unsigned char*)d_ws;
#if MK_N_LAUNCHES == 1
    a.ph_lo = 0; a.ph_hi = NPHASES;
    void* params[] = {&a};
    hipError_t e = hipLaunchCooperativeKernel((const void*)mk_fwd, dim3(grid), dim3(NTHREADS), params, LDS_BYTES, stream);
    if (e != hipSuccess) fprintf(stderr, "kernel_launch: cooperative launch failed: %s (grid %d)\n", hipGetErrorString(e), grid);
#else
    for (int ph = 0; ph < NPHASES; ++ph) {
        if (ph == 6) continue;
        a.ph_lo = ph; a.ph_hi = (ph == 5) ? 7 : ph + 1;
        hipLaunchKernelGGL(mk_fwd, dim3(grid), dim3(NTHREADS), LDS_BYTES, stream, a);
    }
#endif
}
```

```cpp
#include <hip/hip_runtime.h>
#include <hip/hip_cooperative_groups.h>
#include <cstdio>
#include <cstdint>
namespace cg = cooperative_groups;
#define MK_N_LAUNCHES 1

namespace pg8 {
#define PG8_LAS __attribute__((address_space(3)))
typedef unsigned short bf16_t;
typedef short bf16x8 __attribute__((ext_vector_type(8)));
typedef float f32x4 __attribute__((ext_vector_type(4)));
typedef unsigned u32x4 __attribute__((ext_vector_type(4)));
constexpr int BM = 256, BK = 64, HALF = 128, HTB = HALF * BK * 2  , STAGE_BYTES = 8 * HTB, NXCD = 8, WGM = 4;

__host__ __device__ __forceinline__ int lds_byte(int r, int c) { const int st = (r >> 4) * 2 + (c >> 5), rr = r & 15, cc = c & 31, ob = rr * 64 + cc * 2; return st * 1024 + (ob ^ (((ob >> 9) & 1) << 5)); }
__host__ __device__ __forceinline__ void stage_rc(int b, int& R, int& C) { const int st = b / 1024, sb = b % 1024, swz = sb ^ (((sb >> 9) & 1) << 5); R = (st >> 1) * 16 + swz / 64; C = (st & 1) * 32 + (swz % 64) / 2; }
__host__ __device__ __forceinline__ int perm32(int rho) { const int n = rho >> 4, i = rho & 15; return 8 * (i >> 2) + 4 * n + (i & 3); }

struct Unit { int pm, pn; };
struct Gemm { const bf16_t* A; const bf16_t* Bt; int M, N, K; };

struct StaticOrder {
    int nM, nN, nwg, G, c;
    __host__ __device__ void init(int M, int N, int G_, int c_) { nM = M / BM; nN = N / BM; nwg = nM * nN; G = G_; c = c_; }
    __host__ __device__ bool next(int i, Unit& u) const {
        const long L = (long)i * G + c; if (L >= nwg) return false;
        int wgid = (int)L; { const int q = nwg / NXCD, r = nwg % NXCD, xcd = wgid % NXCD, off = wgid / NXCD; wgid = (xcd < r ? xcd * (q + 1) : r * (q + 1) + (xcd - r) * q) + off; }
        const int nig = WGM * nN, gid = wgid / nig, fm = gid * WGM, gsz = (nM - fm) < WGM ? (nM - fm) : WGM;
        u.pm = fm + ((wgid % nig) % gsz); u.pn = (wgid % nig) / gsz; return true;
    }
    __device__ __forceinline__ void a_ready(const Unit&) const {}
    __device__ __forceinline__ void done(const Unit&) const {}
};

typedef __bf16 bf16x2_t __attribute__((ext_vector_type(2)));
typedef float f32x2 __attribute__((ext_vector_type(2)));
__device__ __forceinline__ unsigned cvt_pk_bf16(float lo, float hi) { const f32x2 f = {lo, hi}; return __builtin_bit_cast(unsigned, __builtin_convertvector(f, bf16x2_t)); }
template <class Epi, class Sched, bool ALIGN_EPI = false, bool SP2 = false>
__device__ __forceinline__ void gemm_phase(PG8_LAS unsigned char* lds, const Gemm g, const Sched& S, const Epi& E) {
    const int tid = threadIdx.x, wid = __builtin_amdgcn_readfirstlane(tid >> 6), lane = tid & 63, wr = wid >> 2, wc = wid & 3, fr = lane & 15, fq = lane >> 4;
    const int K = g.K, nt = K / BK;
    unsigned voffA[2], voffB[2];
#pragma unroll
    for (int i = 0; i < 2; ++i) { int R, C; stage_rc(tid * 16 + i * 8192, R, C); const int Rb = Epi::PERM ? ((R & ~31) + perm32(R & 31)) : R;
        voffA[i] = (unsigned)(R * K + C) * 2u; voffB[i] = (unsigned)(Rb * K + C) * 2u; }
    const size_t kstep = (size_t)(BK * 2);
    const size_t hstep = (size_t)HALF * K * 2;
    const size_t tstep = 2 * hstep;
    const unsigned ldsw = (unsigned)wid * 1024u;
    const int aoff = lds_byte(wr * 64 + fr, fq * 8), boff = lds_byte(wc * 32 + fr, fq * 8);
#define PG8_SA(b, h) (((b) * 2 + (h)) * HTB)
#define PG8_SB(b, h) ((4 + (b) * 2 + (h)) * HTB)
#define PG8_STAGE(bufoff, gbase, voff) do { _Pragma("unroll") for (int _i = 0; _i < 2; ++_i) \
        __builtin_amdgcn_global_load_lds((const unsigned*)((const char*)(gbase) + (voff)[_i]), (PG8_LAS unsigned*)(lds + (bufoff) + ldsw + _i * 8192), 16, 0, 0); } while (0)
#define PG8_LDA(dst, b, h) do { _Pragma("unroll") for (int m = 0; m < 4; ++m) _Pragma("unroll") for (int k = 0; k < 2; ++k) dst[m][k] = *(const PG8_LAS bf16x8*)(lds + PG8_SA(b, h) + aoff + m * 2048 + k * 1024); } while (0)
#define PG8_LDB(dst, b, h) do { _Pragma("unroll") for (int n = 0; n < 2; ++n) _Pragma("unroll") for (int k = 0; k < 2; ++k) dst[n][k] = *(const PG8_LAS bf16x8*)(lds + PG8_SB(b, h) + boff + n * 2048 + k * 1024); } while (0)
#define PG8_MMA(ai, bj, At, Bt) do { __builtin_amdgcn_s_setprio(1); _Pragma("unroll") for (int m = 0; m < 4; ++m) _Pragma("unroll") for (int n = 0; n < 2; ++n) _Pragma("unroll") for (int k = 0; k < 2; ++k) \
        acc[ai][bj][m][n] = __builtin_amdgcn_mfma_f32_16x16x32_bf16(Bt[n][k], At[m][k], acc[ai][bj][m][n], 0, 0, 0); __builtin_amdgcn_s_setprio(0); } while (0)
#define PG8_WAIT_V(n) asm volatile("s_waitcnt vmcnt(" #n ")" ::: "memory")
#define PG8_WAIT_L(n) asm volatile("s_waitcnt lgkmcnt(" #n ")" ::: "memory")
#define PG8_BAR __builtin_amdgcn_s_barrier()
#define PG8_SCHED __builtin_amdgcn_sched_barrier(0)
    Unit cur, nxt; int ui = 0;
    if (!S.next(0, cur)) return;
    f32x4 acc[2][2][4][2];
#pragma unroll
    for (int a = 0; a < 2; ++a)
#pragma unroll
        for (int b = 0; b < 2; ++b)
#pragma unroll
            for (int m = 0; m < 4; ++m)
#pragma unroll
                for (int n = 0; n < 2; ++n) acc[a][b][m][n] = (f32x4){0.f, 0.f, 0.f, 0.f};
    bf16x8 At[4][2], B0[2][2], B1[2][2];
    const char* cA = (const char*)g.A + (size_t)cur.pm * tstep; const char* cB = (const char*)g.Bt + (size_t)cur.pn * tstep;
    S.a_ready(cur);
    if constexpr (SP2) {
        PG8_STAGE(PG8_SB(0, 0), cB, voffB); PG8_STAGE(PG8_SB(0, 1), cB + hstep, voffB); PG8_STAGE(PG8_SA(0, 0), cA, voffA); PG8_STAGE(PG8_SA(0, 1), cA + hstep, voffA);
        if (wr == 1) PG8_BAR;
        PG8_WAIT_V(2); PG8_BAR;
        PG8_STAGE(PG8_SB(1, 0), cB + kstep, voffB); PG8_STAGE(PG8_SA(1, 0), cA + kstep, voffA); PG8_STAGE(PG8_SB(1, 1), cB + hstep + kstep, voffB);
        PG8_WAIT_V(6); PG8_BAR;
    } else {
        PG8_STAGE(PG8_SB(0, 0), cB, voffB); PG8_STAGE(PG8_SA(0, 0), cA, voffA); PG8_STAGE(PG8_SB(0, 1), cB + hstep, voffB); PG8_STAGE(PG8_SA(0, 1), cA + hstep, voffA);
        if (wr == 1) PG8_BAR;
        PG8_WAIT_V(4); PG8_BAR;
        PG8_STAGE(PG8_SB(1, 0), cB + kstep, voffB); PG8_STAGE(PG8_SA(1, 0), cA + kstep, voffA); PG8_STAGE(PG8_SB(1, 1), cB + hstep + kstep, voffB);
        PG8_WAIT_V(6); PG8_BAR;
    }
    for (;;) {
        const bool has_next = S.next(ui + 1, nxt);
        const char* nA = has_next ? (const char*)g.A + (size_t)nxt.pm * tstep : cA; const char* nB = has_next ? (const char*)g.Bt + (size_t)nxt.pn * tstep : cB;
        for (int t = 0; t < nt; t += 2) {
            const bool last = (t == nt - 2);
            const char* a1 = cA + (size_t)(t + 1) * kstep;
            const char* a2 = last ? nA : cA + (size_t)(t + 2) * kstep; const char* b2 = last ? nB : cB + (size_t)(t + 2) * kstep;
            const char* a3 = a2 + kstep; const char* b3 = b2 + kstep;
            if (last && has_next) S.a_ready(nxt);
            if constexpr (SP2) {
            PG8_LDB(B0, 0, 0); PG8_LDB(B1, 0, 1); PG8_SCHED; PG8_LDA(At, 0, 0); PG8_STAGE(PG8_SA(1, 1), a1 + hstep, voffA);
            PG8_WAIT_V(8); PG8_WAIT_L(0); PG8_BAR; PG8_MMA(0, 0, At, B0); PG8_MMA(0, 1, At, B1); PG8_BAR; PG8_SCHED;
            PG8_LDA(At, 0, 1); PG8_STAGE(PG8_SB(0, 0), b2, voffB); PG8_STAGE(PG8_SB(0, 1), b2 + hstep, voffB); PG8_STAGE(PG8_SA(0, 0), a2, voffA);
            PG8_WAIT_V(8); PG8_WAIT_L(0); PG8_BAR; PG8_MMA(1, 0, At, B0); PG8_MMA(1, 1, At, B1); PG8_BAR; PG8_SCHED;
            PG8_LDB(B0, 1, 0); PG8_LDB(B1, 1, 1); PG8_SCHED; PG8_LDA(At, 1, 0); PG8_STAGE(PG8_SA(0, 1), a2 + hstep, voffA);
            PG8_WAIT_V(8); PG8_WAIT_L(0); PG8_BAR; PG8_MMA(0, 0, At, B0); PG8_MMA(0, 1, At, B1); PG8_BAR; PG8_SCHED;
            PG8_LDA(At, 1, 1); PG8_STAGE(PG8_SB(1, 0), b3, voffB); PG8_STAGE(PG8_SB(1, 1), b3 + hstep, voffB); PG8_STAGE(PG8_SA(1, 0), a3, voffA);
            PG8_WAIT_V(8); PG8_WAIT_L(0); PG8_BAR; PG8_MMA(1, 0, At, B0); PG8_MMA(1, 1, At, B1); PG8_BAR; PG8_SCHED;
            } else {
            PG8_LDB(B0, 0, 0); PG8_SCHED; PG8_LDA(At, 0, 0); PG8_STAGE(PG8_SA(1, 1), a1 + hstep, voffA);
            PG8_WAIT_L(8); PG8_BAR; PG8_WAIT_L(0); PG8_MMA(0, 0, At, B0); PG8_BAR; PG8_SCHED;
            PG8_LDB(B1, 0, 1); PG8_STAGE(PG8_SB(0, 0), b2, voffB);
            PG8_BAR; PG8_WAIT_L(0); PG8_MMA(0, 1, At, B1); PG8_BAR;
            PG8_LDA(At, 0, 1); PG8_STAGE(PG8_SA(0, 0), a2, voffA);
            PG8_BAR; PG8_WAIT_L(0); PG8_MMA(1, 0, At, B0); PG8_BAR; PG8_SCHED;
            PG8_STAGE(PG8_SB(0, 1), b2 + hstep, voffB);
            PG8_WAIT_V(6); PG8_BAR; PG8_MMA(1, 1, At, B1); PG8_BAR;
            PG8_LDB(B0, 1, 0); PG8_SCHED; PG8_LDA(At, 1, 0); PG8_STAGE(PG8_SA(0, 1), a2 + hstep, voffA);
            PG8_WAIT_L(8); PG8_BAR; PG8_WAIT_L(0); PG8_MMA(0, 0, At, B0); PG8_BAR; PG8_SCHED;
            PG8_LDB(B1, 1, 1); PG8_STAGE(PG8_SB(1, 0), b3, voffB);
            PG8_BAR; PG8_WAIT_L(0); PG8_MMA(0, 1, At, B1); PG8_BAR;
            PG8_LDA(At, 1, 1); PG8_STAGE(PG8_SA(1, 0), a3, voffA);
            PG8_BAR; PG8_WAIT_L(0); PG8_MMA(1, 0, At, B0); PG8_BAR; PG8_SCHED;
            PG8_STAGE(PG8_SB(1, 1), b3 + hstep, voffB);
            PG8_WAIT_V(6); PG8_BAR; PG8_MMA(1, 1, At, B1); PG8_BAR;
            }
        }
        if constexpr (ALIGN_EPI) { if (wr == 0) PG8_BAR; }
        if constexpr (!Epi::AFTER_DRAIN) { E(acc, cur, wr, wc, fr, fq); S.done(cur); }
        if (!has_next) break;
#pragma unroll
        for (int a = 0; a < 2; ++a)
#pragma unroll
            for (int b = 0; b < 2; ++b)
#pragma unroll
                for (int m = 0; m < 4; ++m)
#pragma unroll
                    for (int n = 0; n < 2; ++n) acc[a][b][m][n] = (f32x4){0.f, 0.f, 0.f, 0.f};
        cur = nxt; cA = nA; cB = nB; ++ui;
        if constexpr (ALIGN_EPI) { if (wr == 1) PG8_BAR; }
    }
    PG8_WAIT_V(0);
    if constexpr (!ALIGN_EPI) { if (wr == 0) PG8_BAR; }
    PG8_BAR;
    if constexpr (Epi::AFTER_DRAIN) { E.fused(acc, cur, wr, wc, fr, fq, lds, wid, lane); S.done(cur); }
#undef PG8_SA
#undef PG8_SB
#undef PG8_STAGE
#undef PG8_LDA
#undef PG8_LDB
#undef PG8_MMA
#undef PG8_WAIT_V
#undef PG8_WAIT_L
#undef PG8_BAR
#undef PG8_SCHED
}
}

namespace pg8 {
__device__ __forceinline__ float fsigmoid(float x) { return __builtin_amdgcn_rcpf(1.0f + __builtin_amdgcn_exp2f(x * -1.44269504089f)); }
__device__ __forceinline__ float bflo(unsigned w) { return __uint_as_float(w << 16); }
__device__ __forceinline__ float bfhi(unsigned w) { return __uint_as_float(w & 0xffff0000u); }
constexpr float RMS_EPS = 1e-6f;

struct EpiSwiglu {
    static constexpr bool PERM = true, AFTER_DRAIN = false;
    bf16_t* O; int ldo; const float* ssq; float invd;
    __device__ __forceinline__ void operator()(const f32x4 (&acc)[2][2][4][2], const Unit& u, int wr, int wc, int fr, int fq) const {
        const int row0 = u.pm * BM + wr * 64 + fr, col0 = u.pn * HALF + wc * 32 + 8 * fq;
#pragma unroll
        for (int ai = 0; ai < 2; ++ai)
#pragma unroll
            for (int m = 0; m < 4; ++m) {
                const int row = row0 + ai * HALF + m * 16;
                const float rs = __builtin_amdgcn_rsqf(ssq[row] * invd + RMS_EPS);
                float h[8];
#pragma unroll
                for (int n = 0; n < 2; ++n)
#pragma unroll
                    for (int i = 0; i < 4; ++i) { const float g = acc[ai][0][m][n][i] * rs, up = acc[ai][1][m][n][i] * rs; h[n * 4 + i] = g * fsigmoid(g) * up; }
                u32x4 w; w.x = cvt_pk_bf16(h[0], h[1]); w.y = cvt_pk_bf16(h[2], h[3]); w.z = cvt_pk_bf16(h[4], h[5]); w.w = cvt_pk_bf16(h[6], h[7]);
                *(u32x4*)(O + (size_t)row * ldo + col0) = w;
            }
    }
};

template <bool BF_BASE> struct EpiResidT {
    static constexpr bool PERM = true, AFTER_DRAIN = false;
    const float* basef; const bf16_t* baseb; float* outf; bf16_t* ob; float* ssq_out; int ldc; float alpha;
    __device__ __forceinline__ void operator()(const f32x4 (&acc)[2][2][4][2], const Unit& u, int wr, int wc, int fr, int fq) const {
        const int row0 = u.pm * BM + wr * 64 + fr, col0 = u.pn * BM + wc * 32 + 8 * fq;
#pragma unroll
        for (int ai = 0; ai < 2; ++ai)
#pragma unroll
            for (int m = 0; m < 4; ++m) {
                const int row = row0 + ai * HALF + m * 16; float s = 0.f;
#pragma unroll
                for (int bj = 0; bj < 2; ++bj) {
                    const size_t off = (size_t)row * ldc + col0 + bj * HALF;
                    f32x4 b0, b1;
                    if constexpr (BF_BASE) { const u32x4 p = *(const u32x4*)(baseb + off); b0 = (f32x4){bflo(p.x), bfhi(p.x), bflo(p.y), bfhi(p.y)}; b1 = (f32x4){bflo(p.z), bfhi(p.z), bflo(p.w), bfhi(p.w)}; }
                    else { b0 = *(const f32x4*)(basef + off); b1 = *(const f32x4*)(basef + off + 4); }
                    const f32x4 v0 = b0 + acc[ai][bj][m][0] * alpha, v1 = b1 + acc[ai][bj][m][1] * alpha;
                    if (outf) { *(f32x4*)(outf + off) = v0; *(f32x4*)(outf + off + 4) = v1; }
                    s += (v0[0] * v0[0] + v0[1] * v0[1]) + (v0[2] * v0[2] + v0[3] * v0[3]) + (v1[0] * v1[0] + v1[1] * v1[1]) + (v1[2] * v1[2] + v1[3] * v1[3]);
                    if (ob) { u32x4 w; w.x = cvt_pk_bf16(v0[0], v0[1]); w.y = cvt_pk_bf16(v0[2], v0[3]); w.z = cvt_pk_bf16(v1[0], v1[1]); w.w = cvt_pk_bf16(v1[2], v1[3]); *(u32x4*)(ob + off) = w; }
                }
                s += __shfl_xor(s, 16); s += __shfl_xor(s, 32);
                if (fq == 0) unsafeAtomicAdd(ssq_out + row, s);
            }
    }
};

struct EpiIn {
    static constexpr bool PERM = true, AFTER_DRAIN = false;
    bf16_t* U; bf16_t* GLU; bf16_t* GATES; const float* bgate; const float* ssq; float invd;
    __device__ __forceinline__ void operator()(const f32x4 (&acc)[2][2][4][2], const Unit& u, int wr, int wc, int fr, int fq) const {
        const int row0 = u.pm * BM + wr * 64 + fr, cl = wc * 32 + 8 * fq;
        if (u.pn >= 12) {
            const int colb = (u.pn - 12) * BM + cl;
            f32x4 bv[2][2];
#pragma unroll
            for (int bj = 0; bj < 2; ++bj)
#pragma unroll
                for (int n = 0; n < 2; ++n) bv[bj][n] = *(const f32x4*)(bgate + colb + bj * HALF + 4 * n);
#pragma unroll
            for (int ai = 0; ai < 2; ++ai)
#pragma unroll
                for (int m = 0; m < 4; ++m) {
                    const int row = row0 + ai * HALF + m * 16;
                    const float rs = __builtin_amdgcn_rsqf(ssq[row] * invd + RMS_EPS);
#pragma unroll
                    for (int bj = 0; bj < 2; ++bj) {
                        float h[8];
#pragma unroll
                        for (int n = 0; n < 2; ++n)
#pragma unroll
                            for (int i = 0; i < 4; ++i) h[n * 4 + i] = fsigmoid(acc[ai][bj][m][n][i] * rs + bv[bj][n][i]);
                        u32x4 w; w.x = cvt_pk_bf16(h[0], h[1]); w.y = cvt_pk_bf16(h[2], h[3]); w.z = cvt_pk_bf16(h[4], h[5]); w.w = cvt_pk_bf16(h[6], h[7]);
                        *(u32x4*)(GATES + (size_t)row * 4096 + colb + bj * HALF) = w;
                    }
                }
        } else if (u.pn >= 4) {
            const int colb = (u.pn - 4) * HALF + cl;
#pragma unroll
            for (int ai = 0; ai < 2; ++ai)
#pragma unroll
                for (int m = 0; m < 4; ++m) {
                    const int row = row0 + ai * HALF + m * 16;
                    const float rs = __builtin_amdgcn_rsqf(ssq[row] * invd + RMS_EPS);
                    float h[8];
#pragma unroll
                    for (int n = 0; n < 2; ++n)
#pragma unroll
                        for (int i = 0; i < 4; ++i) h[n * 4 + i] = (acc[ai][0][m][n][i] * rs) * fsigmoid(acc[ai][1][m][n][i] * rs);
                    u32x4 w; w.x = cvt_pk_bf16(h[0], h[1]); w.y = cvt_pk_bf16(h[2], h[3]); w.z = cvt_pk_bf16(h[4], h[5]); w.w = cvt_pk_bf16(h[6], h[7]);
                    *(u32x4*)(GLU + (size_t)row * 1024 + colb) = w;
                }
        } else {
            const int colb = u.pn * BM + cl;
#pragma unroll
            for (int ai = 0; ai < 2; ++ai)
#pragma unroll
                for (int m = 0; m < 4; ++m) {
                    const int row = row0 + ai * HALF + m * 16;
                    const float rs = __builtin_amdgcn_rsqf(ssq[row] * invd + RMS_EPS);
#pragma unroll
                    for (int bj = 0; bj < 2; ++bj) {
                        const f32x4 v0 = acc[ai][bj][m][0] * rs, v1 = acc[ai][bj][m][1] * rs;
                        u32x4 w; w.x = cvt_pk_bf16(v0[0], v0[1]); w.y = cvt_pk_bf16(v0[2], v0[3]); w.z = cvt_pk_bf16(v1[0], v1[1]); w.w = cvt_pk_bf16(v1[2], v1[3]);
                        *(u32x4*)(U + (size_t)row * 1024 + colb + bj * HALF) = w;
                    }
                }
        }
    }
};

struct EpiGateA {
    static constexpr bool PERM = true, AFTER_DRAIN = false;
    bf16_t* GATES;
    __device__ __forceinline__ void operator()(const f32x4 (&acc)[2][2][4][2], const Unit& u, int wr, int wc, int fr, int fq) const {
        const int row0 = u.pm * BM + wr * 64 + fr, col0 = u.pn * BM + wc * 32 + 8 * fq;
#pragma unroll
        for (int ai = 0; ai < 2; ++ai)
#pragma unroll
            for (int m = 0; m < 4; ++m) {
                const int row = row0 + ai * HALF + m * 16;
#pragma unroll
                for (int bj = 0; bj < 2; ++bj) {
                    bf16_t* p = GATES + (size_t)row * 4096 + col0 + bj * HALF;
                    const u32x4 g = *(const u32x4*)p;
                    const f32x4 a0 = acc[ai][bj][m][0], a1 = acc[ai][bj][m][1];
                    u32x4 w; w.x = cvt_pk_bf16(bflo(g.x) * a0[0], bfhi(g.x) * a0[1]); w.y = cvt_pk_bf16(bflo(g.y) * a0[2], bfhi(g.y) * a0[3]);
                    w.z = cvt_pk_bf16(bflo(g.z) * a1[0], bfhi(g.z) * a1[1]); w.w = cvt_pk_bf16(bflo(g.w) * a1[2], bfhi(g.w) * a1[3]);
                    *(u32x4*)p = w;
                }
            }
    }
};
struct EpiGateB {
    static constexpr bool PERM = true, AFTER_DRAIN = false;
    const bf16_t* GATES; const float* bias; bf16_t* MIX;
    __device__ __forceinline__ void operator()(const f32x4 (&acc)[2][2][4][2], const Unit& u, int wr, int wc, int fr, int fq) const {
        const int row0 = u.pm * BM + wr * 64 + fr, col0 = u.pn * BM + wc * 32 + 8 * fq;
        f32x4 bv[2][2];
#pragma unroll
        for (int bj = 0; bj < 2; ++bj)
#pragma unroll
            for (int n = 0; n < 2; ++n) bv[bj][n] = *(const f32x4*)(bias + col0 + bj * HALF + 4 * n);
#pragma unroll
        for (int ai = 0; ai < 2; ++ai)
#pragma unroll
            for (int m = 0; m < 4; ++m) {
                const int row = row0 + ai * HALF + m * 16;
#pragma unroll
                for (int bj = 0; bj < 2; ++bj) {
                    const bf16_t* p = GATES + (size_t)row * 4096 + col0 + bj * HALF;
                    const u32x4 ta = *(const u32x4*)p, g = *(const u32x4*)(p + 2048);
                    const f32x4 a0 = acc[ai][bj][m][0] + bv[bj][0], a1 = acc[ai][bj][m][1] + bv[bj][1];
                    u32x4 w; w.x = cvt_pk_bf16(bflo(ta.x) + bflo(g.x) * a0[0], bfhi(ta.x) + bfhi(g.x) * a0[1]); w.y = cvt_pk_bf16(bflo(ta.y) + bflo(g.y) * a0[2], bfhi(ta.y) + bfhi(g.y) * a0[3]);
                    w.z = cvt_pk_bf16(bflo(ta.z) + bflo(g.z) * a1[0], bfhi(ta.z) + bfhi(g.z) * a1[1]); w.w = cvt_pk_bf16(bflo(ta.w) + bflo(g.w) * a1[2], bfhi(ta.w) + bfhi(g.w) * a1[3]);
                    *(u32x4*)(MIX + (size_t)row * 2048 + col0 + bj * HALF) = w;
                }
            }
    }
};
struct PairOrder {
    StaticOrder S;
    __device__ bool next(int i, Unit& u) const { if (!S.next(i >> 1, u)) return false; if (i & 1) { u.pm += S.nM; u.pn += S.nN; } return true; }
    __device__ __forceinline__ void a_ready(const Unit&) const {}
    __device__ __forceinline__ void done(const Unit&) const {}
};
struct EpiGateAB {
    static constexpr bool PERM = true, AFTER_DRAIN = false;
    EpiGateA a; EpiGateB b; int nM, nN;
    __device__ __forceinline__ void operator()(const f32x4 (&acc)[2][2][4][2], const Unit& u, int wr, int wc, int fr, int fq) const {
        if (u.pm < nM) a(acc, u, wr, wc, fr, fq);
        else { Unit v; v.pm = u.pm - nM; v.pn = u.pn - nN; b(acc, v, wr, wc, fr, fq); }
    }
};
struct EpiFinal {
    static constexpr bool PERM = true, AFTER_DRAIN = true;
    const bf16_t* base; float* out; float* ssq; unsigned* cnt; const float* gain; int ldc; float alpha, invd; unsigned ntn;
    __device__ __forceinline__ void fused(f32x4 (&acc)[2][2][4][2], const Unit& u, int wr, int wc, int fr, int fq, PG8_LAS unsigned char* lds, int wid, int lane) const {
        const int row0 = u.pm * BM + wr * 64 + fr, col0 = u.pn * BM + wc * 32 + 8 * fq;
#pragma unroll
        for (int ai = 0; ai < 2; ++ai)
#pragma unroll
            for (int m = 0; m < 4; ++m) {
                const int row = row0 + ai * HALF + m * 16; float s = 0.f;
#pragma unroll
                for (int bj = 0; bj < 2; ++bj) {
                    const size_t off = (size_t)row * ldc + col0 + bj * HALF;
                    const u32x4 p = *(const u32x4*)(base + off);
                    const f32x4 b0 = (f32x4){bflo(p.x), bfhi(p.x), bflo(p.y), bfhi(p.y)}, b1 = (f32x4){bflo(p.z), bfhi(p.z), bflo(p.w), bfhi(p.w)};
                    const f32x4 v0 = b0 + acc[ai][bj][m][0] * alpha, v1 = b1 + acc[ai][bj][m][1] * alpha;
                    acc[ai][bj][m][0] = v0; acc[ai][bj][m][1] = v1;
                    s += (v0[0] * v0[0] + v0[1] * v0[1]) + (v0[2] * v0[2] + v0[3] * v0[3]) + (v1[0] * v1[0] + v1[1] * v1[1]) + (v1[2] * v1[2] + v1[3] * v1[3]);
                }
                s += __shfl_xor(s, 16); s += __shfl_xor(s, 32);
                if (fq == 0) unsafeAtomicAdd(ssq + row, s);
            }
        asm volatile("s_waitcnt vmcnt(0)" ::: "memory");
        __syncthreads();
        if (threadIdx.x == 0) {
            unsigned* c = cnt + 64 * u.pm;
            __builtin_amdgcn_fence(__ATOMIC_RELEASE, "agent");
            __hip_atomic_fetch_add(c, 1u, __ATOMIC_RELAXED, __HIP_MEMORY_SCOPE_AGENT);
            unsigned sp = 0;
            while (__hip_atomic_load(c, __ATOMIC_RELAXED, __HIP_MEMORY_SCOPE_AGENT) < ntn) { __builtin_amdgcn_s_sleep(2); if (++sp > (1u << 22)) break; }
            __builtin_amdgcn_fence(__ATOMIC_ACQUIRE, "agent");
        }
        __syncthreads();
        f32x4 gv[2][2];
#pragma unroll
        for (int bj = 0; bj < 2; ++bj)
#pragma unroll
            for (int n = 0; n < 2; ++n) gv[bj][n] = *(const f32x4*)(gain + col0 + bj * HALF + 4 * n);
#pragma unroll
        for (int ai = 0; ai < 2; ++ai)
#pragma unroll
            for (int m = 0; m < 4; ++m) {
                const int row = row0 + ai * HALF + m * 16;
                const float rs = __builtin_amdgcn_rsqf(__hip_atomic_load(ssq + row, __ATOMIC_RELAXED, __HIP_MEMORY_SCOPE_AGENT) * invd + RMS_EPS);
#pragma unroll
                for (int bj = 0; bj < 2; ++bj) {
                    const size_t off = (size_t)row * ldc + col0 + bj * HALF;
                    __builtin_nontemporal_store(acc[ai][bj][m][0] * rs * gv[bj][0], (f32x4*)(out + off));
                    __builtin_nontemporal_store(acc[ai][bj][m][1] * rs * gv[bj][1], (f32x4*)(out + off + 4));
                }
            }
    }
};
}

#ifndef MK_N_LAUNCHES
#define MK_N_LAUNCHES 1
#endif
#ifndef MK_SP2
#define MK_SP2 true
#endif
constexpr int NWAVES = 8, NTHREADS = NWAVES * 64;
constexpr int NPHASES = 11;
constexpr int BATCH = 2, T = 4096, D = 2048, M = BATCH * T, FF = 5632, DP = 1024, DC = 1024, DIN = 7168, CONVW = 31;

constexpr size_t MiB = 1u << 20;
constexpr size_t WS_CTL = 0, CTL_ZERO_BYTES = 1 * MiB;
constexpr size_t SSQ0_OFF = 65536, SSQ1_OFF = SSQ0_OFF + 32768, SSQ2_OFF = SSQ1_OFF + 32768, SSQ3_OFF = SSQ2_OFF + 32768;
constexpr size_t WS_W1T = 1 * MiB, WS_WD1T = 45 * MiB, WS_WINT = 67 * MiB, WS_WPOOLT = 95 * MiB, WS_WCONVT = 99 * MiB, WS_WOUTT = 103 * MiB, WS_W2T = 111 * MiB, WS_WD2T = 155 * MiB;
constexpr size_t WS_XB = 177 * MiB, WS_ACT = 209 * MiB, WS_GATES = 297 * MiB, WS_END = 361 * MiB;
constexpr size_t WS_U = WS_ACT, WS_GLU = WS_ACT + 16 * MiB, WS_P = WS_ACT + 32 * MiB, WS_Y = WS_ACT + 48 * MiB, WS_MIX = WS_ACT;
static_assert(WS_W1T + (size_t)2 * FF * D * 2 <= WS_WD1T && WS_WD1T + (size_t)D * FF * 2 <= WS_WINT && WS_WINT + (size_t)DIN * D * 2 <= WS_WPOOLT && WS_WOUTT + (size_t)D * D * 2 <= WS_W2T, "ws map");
static_assert(WS_W2T + (size_t)2 * FF * D * 2 <= WS_WD2T && WS_WD2T + (size_t)D * FF * 2 <= WS_XB && WS_XB + (size_t)M * D * 2 <= WS_ACT && WS_ACT + (size_t)M * FF * 2 <= WS_GATES && WS_GATES + (size_t)M * 4096 * 2 <= WS_END, "ws map");

constexpr int RING_BYTES = 131072, LDS_BYTES = 147456;
constexpr int MISC_OFF = LDS_BYTES - 64;
constexpr size_t CNT_OFF = 32768;
constexpr size_t TRCTR_OFF = 49152;
constexpr size_t DWB_OFF = 262144;
constexpr size_t BAR_OFF = 16384;
constexpr int P0_SCR = 16640;

#define LAS __attribute__((address_space(3)))
typedef unsigned short bf16;
typedef unsigned v4u __attribute__((ext_vector_type(4)));
typedef float f32x4 __attribute__((ext_vector_type(4)));
#define LDS_WAIT() asm volatile("s_waitcnt lgkmcnt(0)" ::: "memory")
using pg8::cvt_pk_bf16; using pg8::bflo; using pg8::bfhi; using pg8::fsigmoid;

__device__ __forceinline__ float wave_sum(float v) {
#pragma unroll
    for (int o = 1; o < 64; o <<= 1) v += __shfl_xor(v, o);
    return v;
}
__device__ __forceinline__ int map_row(int mode, int n0) {
    if (mode == 0) return n0;
    if (mode == 1) return ((n0 >> 7) << 8) + (n0 & 127);
    if (mode == 2) return ((n0 >> 7) << 8) + 128 + (n0 & 127);
    if (n0 < 1024 || n0 >= 3072) return n0;
    if (n0 < 2048) { const int j = n0 - 1024; return 1024 + ((j >> 7) << 8) + (j & 127); }
    const int j = n0 - 2048; return 1024 + ((j >> 7) << 8) + 128 + (j & 127);
}
__device__ __forceinline__ void p0_tr_item(const float* __restrict__ W, int K, int N, const float* __restrict__ gain, bf16* __restrict__ WT, int mode, int item, int lane) {
    const int nblk = N >> 7, kb = item / nblk, nb = item - kb * nblk, k0 = (kb << 6) + ((lane >> 5) << 5), n0 = (nb << 7) + ((lane & 31) << 2);
    const float* src = W + (size_t)k0 * N + n0;
    f32x4 v[32];
#pragma unroll
    for (int i = 0; i < 32; ++i) v[i] = __builtin_nontemporal_load((const f32x4*)(src + (size_t)i * N));
    if (gain) {
#pragma unroll
        for (int i = 0; i < 32; ++i) v[i] *= gain[k0 + i];
    }
    bf16* dst = WT + (size_t)map_row(mode, n0) * K + k0;
#pragma unroll
    for (int j = 0; j < 4; ++j)
#pragma unroll
        for (int q = 0; q < 4; ++q) {
            v4u o; o.x = cvt_pk_bf16(v[8 * q + 0][j], v[8 * q + 1][j]); o.y = cvt_pk_bf16(v[8 * q + 2][j], v[8 * q + 3][j]); o.z = cvt_pk_bf16(v[8 * q + 4][j], v[8 * q + 5][j]); o.w = cvt_pk_bf16(v[8 * q + 6][j], v[8 * q + 7][j]);
            *(v4u*)(dst + (size_t)j * K + 8 * q) = o;
        }
}
__device__ __forceinline__ void p0_fold_item(const float* __restrict__ wg, const float* __restrict__ scale, const float* __restrict__ wp, bf16* __restrict__ WPT, int item, LAS float* scr, int lane) {
    const int nb = item & 31, cb = (item >> 5) & 15, g = item >> 9, n0 = nb << 6, c0 = cb << 4;
#pragma unroll
    for (int ci = 0; ci < 16; ++ci) {
        const f32x4 a = *(const f32x4*)(wg + ((size_t)(g * 256 + c0 + ci)) * 256 + lane * 4), s = *(const f32x4*)(scale + g * 256 + lane * 4);
        *(LAS f32x4*)(scr + ci * 256 + lane * 4) = a * s;
    }
    LDS_WAIT(); asm volatile("" ::: "memory");
    float acc[16];
#pragma unroll
    for (int ci = 0; ci < 16; ++ci) acc[ci] = 0.f;
    const float* bp = wp + (size_t)(g * 256) * D + n0 + lane;
    for (int d = 0; d < 256; d += 4) {
        const float b0 = bp[(size_t)(d + 0) * D], b1 = bp[(size_t)(d + 1) * D], b2 = bp[(size_t)(d + 2) * D], b3 = bp[(size_t)(d + 3) * D];
#pragma unroll
        for (int ci = 0; ci < 16; ++ci) { const f32x4 a = *(const LAS f32x4*)(scr + ci * 256 + d); acc[ci] += (a[0] * b0 + a[1] * b1) + (a[2] * b2 + a[3] * b3); }
    }
    v4u o0, o1;
    o0.x = cvt_pk_bf16(acc[0], acc[1]); o0.y = cvt_pk_bf16(acc[2], acc[3]); o0.z = cvt_pk_bf16(acc[4], acc[5]); o0.w = cvt_pk_bf16(acc[6], acc[7]);
    o1.x = cvt_pk_bf16(acc[8], acc[9]); o1.y = cvt_pk_bf16(acc[10], acc[11]); o1.z = cvt_pk_bf16(acc[12], acc[13]); o1.w = cvt_pk_bf16(acc[14], acc[15]);
    bf16* dst = WPT + (size_t)(n0 + lane) * DP + g * 256 + c0;
    *(v4u*)dst = o0; *(v4u*)(dst + 8) = o1;
    LDS_WAIT(); asm volatile("" ::: "memory");
}
__device__ __forceinline__ void unpack8(const v4u w, float (&f)[8]) { f[0] = bflo(w.x); f[1] = bfhi(w.x); f[2] = bflo(w.y); f[3] = bfhi(w.y); f[4] = bflo(w.z); f[5] = bfhi(w.z); f[6] = bflo(w.w); f[7] = bfhi(w.w); }
__device__ __forceinline__ v4u pack8(const float (&f)[8]) { v4u o; o.x = cvt_pk_bf16(f[0], f[1]); o.y = cvt_pk_bf16(f[2], f[3]); o.z = cvt_pk_bf16(f[4], f[5]); o.w = cvt_pk_bf16(f[6], f[7]); return o; }

template <int HMAX>
__device__ __forceinline__ void p4_pool_half(const bf16* __restrict__ ucol, bf16* __restrict__ pcol, int t0, int h) {
    float s[4][8], u[4][8];
#pragma unroll
    for (int r = 0; r < 4; ++r)
#pragma unroll
        for (int i = 0; i < 8; ++i) s[r][i] = 0.f;
#pragma unroll
    for (int jd = -HMAX; jd < 3 + HMAX; ++jd) {
        const int tt = t0 + jd, ttc = tt < 0 ? 0 : (tt >= T ? T - 1 : tt);
        const unsigned msk = (tt == ttc) ? 0xffffffffu : 0u;
        v4u w = *(const v4u*)(ucol + (size_t)ttc * DP);
        w.x &= msk; w.y &= msk; w.z &= msk; w.w &= msk;
        float f[8]; unpack8(w, f);
#pragma unroll
        for (int r = 0; r < 4; ++r) {
            const int rel = jd - r;
            if (rel >= -HMAX && rel < HMAX) {
                const float mk = (rel >= -h && rel < h) ? 1.f : 0.f;
#pragma unroll
                for (int i = 0; i < 8; ++i) s[r][i] += f[i] * mk;
            }
            if (rel == 0) {
#pragma unroll
                for (int i = 0; i < 8; ++i) u[r][i] = f[i];
            }
        }
    }
#pragma unroll
    for (int r = 0; r < 4; ++r) {
        const int t = t0 + r, lo = t - h < 0 ? 0 : t - h, hi = t + h > T ? T : t + h;
        const float inv = 1.0f / (float)(hi - lo);
        float o[8];
#pragma unroll
        for (int i = 0; i < 8; ++i) o[i] = s[r][i] * inv - u[r][i];
        *(v4u*)(pcol + (size_t)t * DP) = pack8(o);
    }
}
__device__ __forceinline__ void p4_pool_item(const bf16* __restrict__ U, bf16* __restrict__ P, int item, int lane) {
    const int r0 = item * 4, b = r0 / T, t0 = r0 - b * T;
    const bf16* ub = U + (size_t)(b * T) * DP; bf16* pb = P + (size_t)(b * T) * DP;
    p4_pool_half<2>(ub + lane * 8, pb + lane * 8, t0, 1 << (lane >> 5));
    p4_pool_half<8>(ub + 512 + lane * 8, pb + 512 + lane * 8, t0, 4 << (lane >> 5));
}
__device__ __forceinline__ const char* uniform_ptr(const void* p) {
    const unsigned long long v = (unsigned long long)p;
    const unsigned lo = __builtin_amdgcn_readfirstlane((unsigned)v), hi = __builtin_amdgcn_readfirstlane((unsigned)(v >> 32));
    return (const char*)(((unsigned long long)hi << 32) | lo);
}
constexpr int CONV_GS = 12, CONV_NG = (CONVW + 3 + CONV_GS) / CONV_GS;
struct ConvGrp { v4u g[CONV_GS], w[CONV_GS]; };
__device__ __forceinline__ void p4_conv_load(ConvGrp& G, const bf16* __restrict__ gbase, const bf16* __restrict__ wbase, int coff, int t0, int jj) {
#pragma unroll
    for (int u = 0; u < CONV_GS; ++u) {
        const int j = jj * CONV_GS + u, jc = j < CONVW ? j : CONVW - 1;
        G.w[u] = *(const v4u*)(uniform_ptr(wbase + jc * DC) + (unsigned)coff * 2u);
        const int t = t0 - 15 + j, tc = t < 0 ? 0 : (t >= T ? T - 1 : t);
        G.g[u] = *(const v4u*)(uniform_ptr(gbase + (size_t)tc * DC) + (unsigned)coff * 2u);
    }
}
__device__ __forceinline__ void p4_conv_half(const bf16* __restrict__ gbase, const bf16* __restrict__ wbase, int coff, int t0, float (&acc)[4][8]) {
    float w[4][8];
#pragma unroll
    for (int u = 0; u < 4; ++u)
#pragma unroll
        for (int i = 0; i < 8; ++i) w[u][i] = 0.f;
#pragma unroll 1
    for (int jj = 0; jj < CONV_NG; ++jj) {
        ConvGrp cur;
        p4_conv_load(cur, gbase, wbase, coff, t0, jj);
#pragma unroll
        for (int u = 0; u < CONV_GS; ++u) {
            const int j = jj * CONV_GS + u, t = t0 - 15 + j;
            const float wm = j < CONVW ? 1.f : 0.f;
            const unsigned msk = (t >= 0 && t < T) ? 0xffffffffu : 0u;
            { float wf[8]; unpack8(cur.w[u], wf);
#pragma unroll
              for (int i = 0; i < 8; ++i) w[u & 3][i] = wf[i] * wm; }
            v4u ga = cur.g[u]; ga.x &= msk; ga.y &= msk; ga.z &= msk; ga.w &= msk;
            float g[8]; unpack8(ga, g);
#pragma unroll
            for (int r = 0; r < 4; ++r)
#pragma unroll
                for (int i = 0; i < 8; ++i) acc[r][i] += w[(u - r) & 3][i] * g[i];
        }
    }
}
__device__ __forceinline__ void p4_conv_item(const bf16* __restrict__ GLU, const bf16* __restrict__ dww, const float* __restrict__ dwb, const float* __restrict__ lng, const float* __restrict__ lnb,
                                             bf16* __restrict__ Y, int item, int lane) {
    const int r0 = item * 4, b = r0 / T, t0 = r0 - b * T;
    const int cA = lane * 8, cB = 512 + lane * 8;
    const bf16* gb = GLU + (size_t)(b * T) * DC;
    float accA[4][8], accB[4][8];
    asm volatile("" ::: "memory");
    {
        const f32x4 b0 = *(const f32x4*)(dwb + cA), b1 = *(const f32x4*)(dwb + cA + 4), b2 = *(const f32x4*)(dwb + cB), b3 = *(const f32x4*)(dwb + cB + 4);
#pragma unroll
        for (int r = 0; r < 4; ++r)
#pragma unroll
            for (int i = 0; i < 4; ++i) { accA[r][i] = b0[i]; accA[r][4 + i] = b1[i]; accB[r][i] = b2[i]; accB[r][4 + i] = b3[i]; }
    }
    p4_conv_half(gb, dww, cA, t0, accA);
    __builtin_amdgcn_sched_barrier(0);
    p4_conv_half(gb, dww, cB, t0, accB);
    f32x4 lg[4], lb[4];
    asm volatile("" ::: "memory");
    lg[0] = *(const f32x4*)(lng + cA); lg[1] = *(const f32x4*)(lng + cA + 4); lg[2] = *(const f32x4*)(lng + cB); lg[3] = *(const f32x4*)(lng + cB + 4);
    lb[0] = *(const f32x4*)(lnb + cA); lb[1] = *(const f32x4*)(lnb + cA + 4); lb[2] = *(const f32x4*)(lnb + cB); lb[3] = *(const f32x4*)(lnb + cB + 4);
#pragma unroll
    for (int r = 0; r < 4; ++r) {
        float s = 0.f;
#pragma unroll
        for (int i = 0; i < 8; ++i) s += accA[r][i] + accB[r][i];
        const float mu = wave_sum(s) * (1.0f / DC);
        float q = 0.f;
#pragma unroll
        for (int i = 0; i < 8; ++i) { accA[r][i] -= mu; accB[r][i] -= mu; q += accA[r][i] * accA[r][i] + accB[r][i] * accB[r][i]; }
        const float rstd = __builtin_amdgcn_rsqf(wave_sum(q) * (1.0f / DC) + pg8::RMS_EPS);
        float oa[8], ob[8];
#pragma unroll
        for (int i = 0; i < 8; ++i) {
            const float ya = accA[r][i] * rstd * lg[i >> 2][i & 3] + lb[i >> 2][i & 3], yb = accB[r][i] * rstd * lg[2 + (i >> 2)][i & 3] + lb[2 + (i >> 2)][i & 3];
            oa[i] = ya * fsigmoid(ya); ob[i] = yb * fsigmoid(yb);
        }
        bf16* yr = Y + (size_t)(r0 + r) * DC;
        *(v4u*)(yr + cA) = pack8(oa); *(v4u*)(yr + cB) = pack8(ob);
    }
}

#define RLX_AGENT __ATOMIC_RELAXED, __HIP_MEMORY_SCOPE_AGENT
#define XB_TMO      128
#define XB_XCNT(j)  (256  + 64 * (j))
#define XB_XSUB(j)  (1280 + 64 * (j))
#define XB_XGEN(j)  (2304 + 64 * (j))
#define XB_TOP      3328
#define XB_TOPGEN   3392
#define XCD_BAR_WORDS 3456
#define XB_SPIN_CAP (1u << 18)

__device__ __forceinline__ unsigned xb_ld(unsigned* p)              { return __hip_atomic_load(p, __ATOMIC_RELAXED, __HIP_MEMORY_SCOPE_AGENT); }
__device__ __forceinline__ unsigned xb_add(unsigned* p, unsigned v) { return __hip_atomic_fetch_add(p, v, __ATOMIC_RELAXED, __HIP_MEMORY_SCOPE_AGENT); }
__device__ __forceinline__ unsigned xb_xcc_id() { return (unsigned)__builtin_amdgcn_s_getreg((3 << 11) | 20) & 0xFu; }
#define XB_SPIN(cond, bar) do { unsigned _sp = 0; while (cond) { __builtin_amdgcn_s_sleep(1); \
    if ((++_sp & 255u) == 0u) { if (xb_ld(&(bar)[XB_TMO])) break; if (_sp > XB_SPIN_CAP) { atomicAdd(&(bar)[XB_TMO], 1u); break; } } } } while (0)

struct XcdBarrier {
    unsigned* bar; unsigned x;
    volatile LAS unsigned* st;
};

__device__ __forceinline__ XcdBarrier xcd_barrier_post(unsigned* bar, volatile LAS unsigned* st) {
    XcdBarrier b; b.bar = bar; b.x = xb_xcc_id(); b.st = st;
    if (threadIdx.x == 0) (void)xb_add(&bar[XB_XCNT(b.x)], 1u);
    return b;
}
__device__ __forceinline__ void xcd_barrier_complete(unsigned* bar, unsigned x, unsigned& nloc, unsigned& nx) {
    const unsigned G = gridDim.x * gridDim.y * gridDim.z;
    unsigned sum, cnt, mine, sp = 0u;
    for (;;) {
        sum = 0u; cnt = 0u; mine = 0u;
#pragma unroll
        for (unsigned j = 0; j < 16; ++j) { const unsigned c = xb_ld(&bar[XB_XCNT(j)]); sum += c; cnt += (c > 0u) ? 1u : 0u; mine = (j == x) ? c : mine; }
        if (sum == G) break;
        __builtin_amdgcn_s_sleep(1);
        if ((++sp & 255u) == 0u) { if (xb_ld(&bar[XB_TMO])) break; if (sp > XB_SPIN_CAP) { atomicAdd(&bar[XB_TMO], 1u); break; } }
    }
    nloc = mine > 0u ? mine : 1u; nx = cnt > 0u ? cnt : 1u;
}

__device__ __forceinline__ void xcd_barrier(const XcdBarrier& b) {
    asm volatile("s_waitcnt vmcnt(0)" ::: "memory");
    __syncthreads();
    if (threadIdx.x == 0) {
        unsigned* bar = b.bar;
        __builtin_amdgcn_s_waitcnt(0);
        unsigned nloc = b.st[0], nx = b.st[1];
        if (nloc == 0u) { xcd_barrier_complete(bar, b.x, nloc, nx); b.st[0] = nloc; b.st[1] = nx; }
        const unsigned old = xb_add(&bar[XB_XSUB(b.x)], 1u);
        const unsigned gen = old / nloc;
        if (old + 1u == (gen + 1u) * nloc) {
            __builtin_amdgcn_fence(__ATOMIC_RELEASE, "agent");
            asm volatile("s_waitcnt vmcnt(0)" ::: "memory");
            const unsigned og = xb_add(&bar[XB_TOP], 1u);
            const unsigned tg = og / nx;
            if (og + 1u == (tg + 1u) * nx) xb_add(&bar[XB_TOPGEN], 1u);
            else XB_SPIN(xb_ld(&bar[XB_TOPGEN]) == tg, bar);
            __builtin_amdgcn_fence(__ATOMIC_ACQUIRE, "agent");
            xb_add(&bar[XB_XGEN(b.x)], 1u);
            asm volatile("s_waitcnt vmcnt(0)" ::: "memory");
        } else {
            XB_SPIN(xb_ld(&bar[XB_XGEN(b.x)]) == gen, bar);
            __builtin_amdgcn_fence(__ATOMIC_ACQUIRE, "agent");
            asm volatile("s_waitcnt vmcnt(0)" ::: "memory");
        }
    }
    __syncthreads();
}
struct Args { const float* in[23]; float* out; unsigned char* ws; int ph_lo, ph_hi; };

constexpr int I_GU = (D / 64) * (FF / 128), I_DN = (FF / 64) * (D / 128), I_IN = (D / 64) * (DIN / 128), I_CV = (DC / 64) * (D / 128), I_WO = (D / 64) * (D / 128), I_FOLD = 4 * 16 * 32;
constexpr int TR_W1U = I_GU, TR_WD1 = 2 * I_GU, TR_WIN = TR_WD1 + I_DN, TR_CV = TR_WIN + I_IN, TR_WO = TR_CV + I_CV, TR_W2G = TR_WO + I_WO, TR_W2U = TR_W2G + I_GU, TR_WD2 = TR_W2U + I_GU, TR_END = TR_WD2 + I_DN;
#ifndef MK_TR_C0
#define MK_TR_C0 TR_WD1
#endif
#ifndef MK_TR_C1
#define MK_TR_C1 TR_W2G
#endif
#ifndef MK_TR_C2
#define MK_TR_C2 TR_WD2
#endif
constexpr int TR_C0 = MK_TR_C0, TR_C1 = MK_TR_C1, TR_C2 = MK_TR_C2;
static_assert(TR_C0 >= TR_WD1 && TR_C1 >= TR_CV && TR_C1 >= TR_C0 && TR_C2 >= TR_C1, "conversion segments follow the phases' dependencies");
__device__ __forceinline__ void tr_run(const Args& args, int lo, int hi, int worker, int nworkers, int lane) {
    unsigned char* ws = args.ws;
    for (int g = lo + worker; g < hi; g += nworkers) {
        if (g < TR_W1U)      p0_tr_item(args.in[2],  D,  FF,  args.in[1],  (bf16*)(ws + WS_W1T),    1, g,          lane);
        else if (g < TR_WD1) p0_tr_item(args.in[3],  D,  FF,  args.in[1],  (bf16*)(ws + WS_W1T),    2, g - TR_W1U, lane);
        else if (g < TR_WIN) p0_tr_item(args.in[4],  FF, D,   nullptr,     (bf16*)(ws + WS_WD1T),   0, g - TR_WD1, lane);
        else if (g < TR_CV)  p0_tr_item(args.in[6],  D,  DIN, args.in[5],  (bf16*)(ws + WS_WINT),   3, g - TR_WIN, lane);
        else if (g < TR_WO)  p0_tr_item(args.in[15], DC, D,   nullptr,     (bf16*)(ws + WS_WCONVT), 0, g - TR_CV,  lane);
        else if (g < TR_W2G) p0_tr_item(args.in[17], D,  D,   nullptr,     (bf16*)(ws + WS_WOUTT),  0, g - TR_WO,  lane);
        else if (g < TR_W2U) p0_tr_item(args.in[19], D,  FF,  args.in[18], (bf16*)(ws + WS_W2T),    1, g - TR_W2G, lane);
        else if (g < TR_WD2) p0_tr_item(args.in[20], D,  FF,  args.in[18], (bf16*)(ws + WS_W2T),    2, g - TR_W2U, lane);
        else                 p0_tr_item(args.in[21], FF, D,   nullptr,     (bf16*)(ws + WS_WD2T),   0, g - TR_WD2, lane);
    }
}
__device__ __forceinline__ void tr_run_dyn(const Args& args, int lo, int hi, unsigned* ctr, int lane) {
    unsigned char* ws = args.ws;
    for (;;) {
        int g = 0;
        if (lane == 0) g = lo + (int)__hip_atomic_fetch_add(ctr, 1u, __ATOMIC_RELAXED, __HIP_MEMORY_SCOPE_AGENT);
        g = __builtin_amdgcn_readfirstlane(g);
        if (g >= hi) break;
        if (g < TR_W1U)      p0_tr_item(args.in[2],  D,  FF,  args.in[1],  (bf16*)(ws + WS_W1T),    1, g,          lane);
        else if (g < TR_WD1) p0_tr_item(args.in[3],  D,  FF,  args.in[1],  (bf16*)(ws + WS_W1T),    2, g - TR_W1U, lane);
        else if (g < TR_WIN) p0_tr_item(args.in[4],  FF, D,   nullptr,     (bf16*)(ws + WS_WD1T),   0, g - TR_WD1, lane);
        else if (g < TR_CV)  p0_tr_item(args.in[6],  D,  DIN, args.in[5],  (bf16*)(ws + WS_WINT),   3, g - TR_WIN, lane);
        else if (g < TR_WO)  p0_tr_item(args.in[15], DC, D,   nullptr,     (bf16*)(ws + WS_WCONVT), 0, g - TR_CV,  lane);
        else if (g < TR_W2G) p0_tr_item(args.in[17], D,  D,   nullptr,     (bf16*)(ws + WS_WOUTT),  0, g - TR_WO,  lane);
        else if (g < TR_W2U) p0_tr_item(args.in[19], D,  FF,  args.in[18], (bf16*)(ws + WS_W2T),    1, g - TR_W2G, lane);
        else if (g < TR_WD2) p0_tr_item(args.in[20], D,  FF,  args.in[18], (bf16*)(ws + WS_W2T),    2, g - TR_W2U, lane);
        else                 p0_tr_item(args.in[21], FF, D,   nullptr,     (bf16*)(ws + WS_WD2T),   0, g - TR_WD2, lane);
    }
}
__device__ __forceinline__ bool tail_worker(int ntiles, int G, int bid, int wave, int& worker, int& nworkers) {
    const int rounds = (ntiles + G - 1) / G, last = ntiles - (rounds - 1) * G;
    if (last == G) { worker = bid * NWAVES + wave; nworkers = G * NWAVES; return true; }
    if (bid < last) return false;
    worker = (bid - last) * NWAVES + wave; nworkers = (G - last) * NWAVES; return true;
}

__global__ void __launch_bounds__(NTHREADS, 2) mk_fwd(Args args) {
    extern __shared__ __attribute__((aligned(16))) unsigned char lds_raw[];
    LAS unsigned char* lds = (LAS unsigned char*)lds_raw;
    cg::grid_group grid = cg::this_grid();
    const int tid = threadIdx.x, lane = tid & 63, wave = __builtin_amdgcn_readfirstlane(tid >> 6);
    const int G = gridDim.x, gw = blockIdx.x * NWAVES + wave, NGW = G * NWAVES;
    unsigned char* ws = args.ws;
    const float* x = args.in[0];
    float* out = args.out;
    float* ssq0 = (float*)(ws + SSQ0_OFF); float* ssq1 = (float*)(ws + SSQ1_OFF); float* ssq2 = (float*)(ws + SSQ2_OFF); float* ssq3 = (float*)(ws + SSQ3_OFF);
    bf16* W1T = (bf16*)(ws + WS_W1T); bf16* WD1T = (bf16*)(ws + WS_WD1T); bf16* WINT = (bf16*)(ws + WS_WINT); bf16* WPOOLT = (bf16*)(ws + WS_WPOOLT); bf16* WCONVT = (bf16*)(ws + WS_WCONVT);
    bf16* WOUTT = (bf16*)(ws + WS_WOUTT); bf16* W2T = (bf16*)(ws + WS_W2T); bf16* WD2T = (bf16*)(ws + WS_WD2T);
    bf16* XB = (bf16*)(ws + WS_XB); bf16* ACT = (bf16*)(ws + WS_ACT); bf16* GATES = (bf16*)(ws + WS_GATES);
    bf16* UB = (bf16*)(ws + WS_U); bf16* GLUB = (bf16*)(ws + WS_GLU); bf16* PB = (bf16*)(ws + WS_P); bf16* YB = (bf16*)(ws + WS_Y); bf16* MIX = (bf16*)(ws + WS_MIX);
    const int lo = args.ph_lo, hi = args.ph_hi;
    if (lo < 0) grid.sync();
    volatile LAS unsigned* MISC = (volatile LAS unsigned*)(lds + MISC_OFF);
    if (tid < 16) MISC[tid] = 0u;
    __syncthreads();
    XcdBarrier bar = xcd_barrier_post((unsigned*)(ws + BAR_OFF), MISC + 8);
#ifndef MK_PHM
#define MK_PHM 0xffffu
#endif
#define IN(k) (((MK_PHM >> (k)) & 1u) && lo <= (k) && (k) < hi)
#ifndef MK_REP
#define MK_REP 0u
#endif
#define REPS(k) (1 + (int)((MK_REP >> (k)) & 1u))
#define SEAM(k) do { if (IN(k) && IN((k) + 1)) xcd_barrier(bar); } while (0)
    constexpr float INVD = 1.0f / D;

    if (IN(0)) {
        LAS float* scr = (LAS float*)(lds + wave * P0_SCR);
        tr_run(args, 0, TR_C0, gw, NGW, lane);
        for (int it = gw; it < I_FOLD; it += NGW) p0_fold_item(args.in[8], args.in[9], args.in[10], WPOOLT, it, scr, lane);
        for (int i = gw * 64 + lane; i < CONVW * DC / 2; i += NGW * 64) ((unsigned*)(ws + DWB_OFF))[i] = cvt_pk_bf16(args.in[11][2 * i], args.in[11][2 * i + 1]);
        for (int m = gw; m < M; m += NGW) {
            const f32x4* xr = (const f32x4*)(x + (size_t)m * D); float s = 0.f;
#pragma unroll
            for (int j = 0; j < 4; ++j) {
                const f32x4 a = __builtin_nontemporal_load(xr + j * 128 + lane * 2), b = __builtin_nontemporal_load(xr + j * 128 + lane * 2 + 1);
                s += (a[0] * a[0] + a[1] * a[1]) + (a[2] * a[2] + a[3] * a[3]) + (b[0] * b[0] + b[1] * b[1]) + (b[2] * b[2] + b[3] * b[3]);
                v4u o; o.x = cvt_pk_bf16(a[0], a[1]); o.y = cvt_pk_bf16(a[2], a[3]); o.z = cvt_pk_bf16(b[0], b[1]); o.w = cvt_pk_bf16(b[2], b[3]);
                *(v4u*)(XB + (size_t)m * D + j * 512 + lane * 8) = o;
            }
            s = wave_sum(s);
            if (lane == 0) ssq0[m] = s;
        }
        __syncthreads();
    }
    SEAM(0);
    if (IN(1)) {
        pg8::Gemm g{XB, W1T, M, 2 * FF, D}; pg8::StaticOrder S; S.init(M, 2 * FF, G, (int)blockIdx.x);
        pg8::EpiSwiglu E{ACT, FF, ssq0, INVD};
        pg8::gemm_phase<pg8::EpiSwiglu, pg8::StaticOrder, true, MK_SP2>(lds, g, S, E);
        { int worker, nworkers; if (tail_worker((M / 256) * (2 * FF / 256), G, (int)blockIdx.x, wave, worker, nworkers)) tr_run(args, TR_C0, TR_C1, worker, nworkers, lane); }
    }
    SEAM(1);
    if (IN(2)) {
        pg8::Gemm g{ACT, WD1T, M, D, FF}; pg8::StaticOrder S; S.init(M, D, G, (int)blockIdx.x);
        pg8::EpiResidT<false> E{x, nullptr, nullptr, XB, ssq1, D, 0.5f};
        pg8::gemm_phase<pg8::EpiResidT<false>, pg8::StaticOrder, true, MK_SP2>(lds, g, S, E);
    }
    SEAM(2);
    if (IN(3)) {
        pg8::Gemm g{XB, WINT, M, DIN, D}; pg8::StaticOrder S; S.init(M, DIN, G, (int)blockIdx.x);
        pg8::EpiIn E{UB, GLUB, GATES, args.in[7], ssq1, INVD};
        pg8::gemm_phase<pg8::EpiIn, pg8::StaticOrder, true, MK_SP2>(lds, g, S, E);
        { int worker, nworkers; if (tail_worker((M / 256) * (DIN / 256), G, (int)blockIdx.x, wave, worker, nworkers)) tr_run(args, TR_C1, TR_C2, worker, nworkers, lane); }
    }
    SEAM(3);
    if (IN(4)) {
#ifndef NO_CONV
        for (int it = gw; it < M / 4; it += NGW) p4_conv_item(GLUB, (const bf16*)(ws + DWB_OFF), args.in[12], args.in[13], args.in[14], YB, it, lane);
#endif
#ifndef NO_POOL
        for (int it = gw; it < M / 4; it += NGW) p4_pool_item(UB, PB, it, lane);
#endif
        __syncthreads();
    }
    SEAM(4);
    static_assert(WS_Y == WS_P + (size_t)M * DP * 2 && WS_WCONVT == WS_WPOOLT + (size_t)D * DP * 2 && DP == DC, "P | Y and Wpool_t | Wconv_t are adjacent: the conv unit is a row offset into both operands");
    if (IN(5) && IN(6)) {
        pg8::Gemm g{PB, WPOOLT, 2 * M, 2 * D, DP}; pg8::PairOrder S; S.S.init(M, D, G, (int)blockIdx.x);
        pg8::EpiGateAB E{pg8::EpiGateA{GATES}, pg8::EpiGateB{GATES, args.in[16], MIX}, M / 256, D / 256};
        pg8::gemm_phase<pg8::EpiGateAB, pg8::PairOrder, true, MK_SP2>(lds, g, S, E);
    }
    SEAM(6);
    if (IN(7)) {
        pg8::Gemm g{MIX, WOUTT, M, D, D}; pg8::StaticOrder S; S.init(M, D, G, (int)blockIdx.x);
        pg8::EpiResidT<true> E{nullptr, XB, nullptr, XB, ssq2, D, 1.0f};
        pg8::gemm_phase<pg8::EpiResidT<true>, pg8::StaticOrder, true, MK_SP2>(lds, g, S, E);
    }
    SEAM(7);
    if (IN(8)) {
        pg8::Gemm g{XB, W2T, M, 2 * FF, D}; pg8::StaticOrder S; S.init(M, 2 * FF, G, (int)blockIdx.x);
        pg8::EpiSwiglu E{ACT, FF, ssq2, INVD};
        pg8::gemm_phase<pg8::EpiSwiglu, pg8::StaticOrder, true, MK_SP2>(lds, g, S, E);
        { int worker, nworkers; if (tail_worker((M / 256) * (2 * FF / 256), G, (int)blockIdx.x, wave, worker, nworkers)) tr_run(args, TR_C2, TR_END, worker, nworkers, lane); }
    }
    SEAM(8);
    const bool fuse_final = (G == (M / 256) * (D / 256)) && IN(9) && IN(10);
    if (IN(9)) {
        pg8::Gemm g{ACT, WD2T, M, D, FF}; pg8::StaticOrder S; S.init(M, D, G, (int)blockIdx.x);
        if (fuse_final) {
            pg8::EpiFinal E{XB, out, ssq3, (unsigned*)(ws + CNT_OFF), args.in[22], D, 0.5f, INVD, (unsigned)(D / 256)};
            pg8::gemm_phase<pg8::EpiFinal, pg8::StaticOrder, false, MK_SP2>(lds, g, S, E);
        } else {
            pg8::EpiResidT<true> E{nullptr, XB, out, nullptr, ssq3, D, 0.5f};
            pg8::gemm_phase<pg8::EpiResidT<true>, pg8::StaticOrder, true, MK_SP2>(lds, g, S, E);
        }
    }
    if (!fuse_final) SEAM(9);
    if (IN(10) && !fuse_final) {
        const f32x4* gn = (const f32x4*)args.in[22];
        for (int m = gw; m < M; m += NGW) {
            const float rs = __builtin_amdgcn_rsqf(ssq3[m] * INVD + pg8::RMS_EPS);
            f32x4* xr = (f32x4*)(out + (size_t)m * D);
#pragma unroll
            for (int j = 0; j < 8; ++j) { const f32x4 v = __builtin_nontemporal_load(xr + j * 64 + lane); __builtin_nontemporal_store(v * rs * gn[j * 64 + lane], xr + j * 64 + lane); }
        }
    }
#undef IN
#undef SEAM
}

extern "C" void kernel_launch(void* const* d_in, const int* in_sizes, int n_in, void* d_out, int out_size, void* d_ws, size_t ws_size, hipStream_t stream) {
    static int grid = 0;
    if (grid == 0) {
        if (n_in != 23 || in_sizes[0] != M * D || out_size != M * D || ws_size < WS_END) { fprintf(stderr, "kernel_launch: unexpected shapes / workspace (n_in %d, ws %zu, need %zu)\n", n_in, ws_size, (size_t)WS_END); grid = -1; return; }
        int dev = 0, cus = 0, per_cu = 0;
        if (hipGetDevice(&dev) != hipSuccess || hipDeviceGetAttribute(&cus, hipDeviceAttributeMultiprocessorCount, dev) != hipSuccess) { grid = -1; return; }
        if (hipFuncSetAttribute((const void*)mk_fwd, hipFuncAttributeMaxDynamicSharedMemorySize, LDS_BYTES) != hipSuccess) { fprintf(stderr, "kernel_launch: hipFuncSetAttribute failed\n"); grid = -1; return; }
        if (hipOccupancyMaxActiveBlocksPerMultiprocessor(&per_cu, (const void*)mk_fwd, NTHREADS, LDS_BYTES) != hipSuccess || per_cu < 1) { fprintf(stderr, "kernel_launch: occupancy query reports %d blocks per CU\n", per_cu); (void)hipGetLastError(); grid = -1; return; }
        grid = cus;
    }
    if (grid < 0) return;
    (void)hipMemsetAsync((char*)d_ws + WS_CTL, 0, CTL_ZERO_BYTES, stream);
    Args a{};
    for (int i = 0; i < 23; ++i) a.in[i] = (const float*)d_in[i];
    a.out = (float*)d_out; a.ws = (unsigned char*)d_ws;
#if MK_N_LAUNCHES == 1
    a.ph_lo = 0; a.ph_hi = NPHASES;
    void* params[] = {&a};
    hipError_t e = hipLaunchCooperativeKernel((const void*)mk_fwd, dim3(grid), dim3(NTHREADS), params, LDS_BYTES, stream);
    if (e != hipSuccess) fprintf(stderr, "kernel_launch: cooperative launch failed: %s (grid %d)\n", hipGetErrorString(e), grid);
#else
    for (int ph = 0; ph < NPHASES; ++ph) {
        if (ph == 6) continue;
        a.ph_lo = ph; a.ph_hi = (ph == 5) ? 7 : ph + 1;
        hipLaunchKernelGGL(mk_fwd, dim3(grid), dim3(NTHREADS), LDS_BYTES, stream, a);
    }
#endif
}
```

```cpp
#include <hip/hip_runtime.h>
#include <hip/hip_cooperative_groups.h>
#include <cstdio>
#include <cstdint>
namespace cg = cooperative_groups;
#define MK_N_LAUNCHES 1

namespace pg8 {
#define PG8_LAS __attribute__((address_space(3)))
typedef unsigned short bf16_t;
typedef short bf16x8 __attribute__((ext_vector_type(8)));
typedef float f32x4 __attribute__((ext_vector_type(4)));
typedef unsigned u32x4 __attribute__((ext_vector_type(4)));
constexpr int BM = 256, BK = 64, HALF = 128, HTB = HALF * BK * 2  , STAGE_BYTES = 8 * HTB, NXCD = 8, WGM = 4;

__host__ __device__ __forceinline__ int lds_byte(int r, int c) { const int st = (r >> 4) * 2 + (c >> 5), rr = r & 15, cc = c & 31, ob = rr * 64 + cc * 2; return st * 1024 + (ob ^ (((ob >> 9) & 1) << 5)); }
__host__ __device__ __forceinline__ void stage_rc(int b, int& R, int& C) { const int st = b / 1024, sb = b % 1024, swz = sb ^ (((sb >> 9) & 1) << 5); R = (st >> 1) * 16 + swz / 64; C = (st & 1) * 32 + (swz % 64) / 2; }
__host__ __device__ __forceinline__ int perm32(int rho) { const int n = rho >> 4, i = rho & 15; return 8 * (i >> 2) + 4 * n + (i & 3); }

struct Unit { int pm, pn; };
struct Gemm { const bf16_t* A; const bf16_t* Bt; int M, N, K; };

struct StaticOrder {
    int nM, nN, nwg, G, c;
    __host__ __device__ void init(int M, int N, int G_, int c_) { nM = M / BM; nN = N / BM; nwg = nM * nN; G = G_; c = c_; }
    __host__ __device__ bool next(int i, Unit& u) const {
        const long L = (long)i * G + c; if (L >= nwg) return false;
        int wgid = (int)L; { const int q = nwg / NXCD, r = nwg % NXCD, xcd = wgid % NXCD, off = wgid / NXCD; wgid = (xcd < r ? xcd * (q + 1) : r * (q + 1) + (xcd - r) * q) + off; }
        const int nig = WGM * nN, gid = wgid / nig, fm = gid * WGM, gsz = (nM - fm) < WGM ? (nM - fm) : WGM;
        u.pm = fm + ((wgid % nig) % gsz); u.pn = (wgid % nig) / gsz; return true;
    }
    __device__ __forceinline__ void a_ready(const Unit&) const {}
    __device__ __forceinline__ void done(const Unit&) const {}
};

typedef __bf16 bf16x2_t __attribute__((ext_vector_type(2)));
typedef float f32x2 __attribute__((ext_vector_type(2)));
__device__ __forceinline__ unsigned cvt_pk_bf16(float lo, float hi) { const f32x2 f = {lo, hi}; return __builtin_bit_cast(unsigned, __builtin_convertvector(f, bf16x2_t)); }
template <class Epi, class Sched, bool ALIGN_EPI = false, bool SP2 = false>
__device__ __forceinline__ void gemm_phase(PG8_LAS unsigned char* lds, const Gemm g, const Sched& S, const Epi& E) {
    const int tid = threadIdx.x, wid = __builtin_amdgcn_readfirstlane(tid >> 6), lane = tid & 63, wr = wid >> 2, wc = wid & 3, fr = lane & 15, fq = lane >> 4;
    const int K = g.K, nt = K / BK;
    unsigned voffA[2], voffB[2];
#pragma unroll
    for (int i = 0; i < 2; ++i) { int R, C; stage_rc(tid * 16 + i * 8192, R, C); const int Rb = Epi::PERM ? ((R & ~31) + perm32(R & 31)) : R;
        voffA[i] = (unsigned)(R * K + C) * 2u; voffB[i] = (unsigned)(Rb * K + C) * 2u; }
    const size_t kstep = (size_t)(BK * 2);
    const size_t hstep = (size_t)HALF * K * 2;
    const size_t tstep = 2 * hstep;
    const unsigned ldsw = (unsigned)wid * 1024u;
    const int aoff = lds_byte(wr * 64 + fr, fq * 8), boff = lds_byte(wc * 32 + fr, fq * 8);
#define PG8_SA(b, h) (((b) * 2 + (h)) * HTB)
#define PG8_SB(b, h) ((4 + (b) * 2 + (h)) * HTB)
#define PG8_STAGE(bufoff, gbase, voff) do { _Pragma("unroll") for (int _i = 0; _i < 2; ++_i) \
        __builtin_amdgcn_global_load_lds((const unsigned*)((const char*)(gbase) + (voff)[_i]), (PG8_LAS unsigned*)(lds + (bufoff) + ldsw + _i * 8192), 16, 0, 0); } while (0)
#define PG8_LDA(dst, b, h) do { _Pragma("unroll") for (int m = 0; m < 4; ++m) _Pragma("unroll") for (int k = 0; k < 2; ++k) dst[m][k] = *(const PG8_LAS bf16x8*)(lds + PG8_SA(b, h) + aoff + m * 2048 + k * 1024); } while (0)
#define PG8_LDB(dst, b, h) do { _Pragma("unroll") for (int n = 0; n < 2; ++n) _Pragma("unroll") for (int k = 0; k < 2; ++k) dst[n][k] = *(const PG8_LAS bf16x8*)(lds + PG8_SB(b, h) + boff + n * 2048 + k * 1024); } while (0)
#define PG8_MMA(ai, bj, At, Bt) do { __builtin_amdgcn_s_setprio(1); _Pragma("unroll") for (int m = 0; m < 4; ++m) _Pragma("unroll") for (int n = 0; n < 2; ++n) _Pragma("unroll") for (int k = 0; k < 2; ++k) \
        acc[ai][bj][m][n] = __builtin_amdgcn_mfma_f32_16x16x32_bf16(Bt[n][k], At[m][k], acc[ai][bj][m][n], 0, 0, 0); __builtin_amdgcn_s_setprio(0); } while (0)
#define PG8_WAIT_V(n) asm volatile("s_waitcnt vmcnt(" #n ")" ::: "memory")
#define PG8_WAIT_L(n) asm volatile("s_waitcnt lgkmcnt(" #n ")" ::: "memory")
#define PG8_BAR __builtin_amdgcn_s_barrier()
#define PG8_SCHED __builtin_amdgcn_sched_barrier(0)
    Unit cur, nxt; int ui = 0;
    if (!S.next(0, cur)) return;
    f32x4 acc[2][2][4][2];
#pragma unroll
    for (int a = 0; a < 2; ++a)
#pragma unroll
        for (int b = 0; b < 2; ++b)
#pragma unroll
            for (int m = 0; m < 4; ++m)
#pragma unroll
                for (int n = 0; n < 2; ++n) acc[a][b][m][n] = (f32x4){0.f, 0.f, 0.f, 0.f};
    bf16x8 At[4][2], B0[2][2], B1[2][2];
    const char* cA = (const char*)g.A + (size_t)cur.pm * tstep; const char* cB = (const char*)g.Bt + (size_t)cur.pn * tstep;
    S.a_ready(cur);
    if constexpr (SP2) {
        PG8_STAGE(PG8_SB(0, 0), cB, voffB); PG8_STAGE(PG8_SB(0, 1), cB + hstep, voffB); PG8_STAGE(PG8_SA(0, 0), cA, voffA); PG8_STAGE(PG8_SA(0, 1), cA + hstep, voffA);
        if (wr == 1) PG8_BAR;
        PG8_WAIT_V(2); PG8_BAR;
        PG8_STAGE(PG8_SB(1, 0), cB + kstep, voffB); PG8_STAGE(PG8_SA(1, 0), cA + kstep, voffA); PG8_STAGE(PG8_SB(1, 1), cB + hstep + kstep, voffB);
        PG8_WAIT_V(6); PG8_BAR;
    } else {
        PG8_STAGE(PG8_SB(0, 0), cB, voffB); PG8_STAGE(PG8_SA(0, 0), cA, voffA); PG8_STAGE(PG8_SB(0, 1), cB + hstep, voffB); PG8_STAGE(PG8_SA(0, 1), cA + hstep, voffA);
        if (wr == 1) PG8_BAR;
        PG8_WAIT_V(4); PG8_BAR;
        PG8_STAGE(PG8_SB(1, 0), cB + kstep, voffB); PG8_STAGE(PG8_SA(1, 0), cA + kstep, voffA); PG8_STAGE(PG8_SB(1, 1), cB + hstep + kstep, voffB);
        PG8_WAIT_V(6); PG8_BAR;
    }
    for (;;) {
        const bool has_next = S.next(ui + 1, nxt);
        const char* nA = has_next ? (const char*)g.A + (size_t)nxt.pm * tstep : cA; const char* nB = has_next ? (const char*)g.Bt + (size_t)nxt.pn * tstep : cB;
        for (int t = 0; t < nt; t += 2) {
            const bool last = (t == nt - 2);
            const char* a1 = cA + (size_t)(t + 1) * kstep;
            const char* a2 = last ? nA : cA + (size_t)(t + 2) * kstep; const char* b2 = last ? nB : cB + (size_t)(t + 2) * kstep;
            const char* a3 = a2 + kstep; const char* b3 = b2 + kstep;
            if (last && has_next) S.a_ready(nxt);
            if constexpr (SP2) {
            PG8_LDB(B0, 0, 0); PG8_LDB(B1, 0, 1); PG8_SCHED; PG8_LDA(At, 0, 0); PG8_STAGE(PG8_SA(1, 1), a1 + hstep, voffA);
            PG8_WAIT_V(8); PG8_WAIT_L(0); PG8_BAR; PG8_MMA(0, 0, At, B0); PG8_MMA(0, 1, At, B1); PG8_BAR; PG8_SCHED;
            PG8_LDA(At, 0, 1); PG8_STAGE(PG8_SB(0, 0), b2, voffB); PG8_STAGE(PG8_SB(0, 1), b2 + hstep, voffB); PG8_STAGE(PG8_SA(0, 0), a2, voffA);
            PG8_WAIT_V(8); PG8_WAIT_L(0); PG8_BAR; PG8_MMA(1, 0, At, B0); PG8_MMA(1, 1, At, B1); PG8_BAR; PG8_SCHED;
            PG8_LDB(B0, 1, 0); PG8_LDB(B1, 1, 1); PG8_SCHED; PG8_LDA(At, 1, 0); PG8_STAGE(PG8_SA(0, 1), a2 + hstep, voffA);
            PG8_WAIT_V(8); PG8_WAIT_L(0); PG8_BAR; PG8_MMA(0, 0, At, B0); PG8_MMA(0, 1, At, B1); PG8_BAR; PG8_SCHED;
            PG8_LDA(At, 1, 1); PG8_STAGE(PG8_SB(1, 0), b3, voffB); PG8_STAGE(PG8_SB(1, 1), b3 + hstep, voffB); PG8_STAGE(PG8_SA(1, 0), a3, voffA);
            PG8_WAIT_V(8); PG8_WAIT_L(0); PG8_BAR; PG8_MMA(1, 0, At, B0); PG8_MMA(1, 1, At, B1); PG8_BAR; PG8_SCHED;
            } else {
            PG8_LDB(B0, 0, 0); PG8_SCHED; PG8_LDA(At, 0, 0); PG8_STAGE(PG8_SA(1, 1), a1 + hstep, voffA);
            PG8_WAIT_L(8); PG8_BAR; PG8_WAIT_L(0); PG8_MMA(0, 0, At, B0); PG8_BAR; PG8_SCHED;
            PG8_LDB(B1, 0, 1); PG8_STAGE(PG8_SB(0, 0), b2, voffB);
            PG8_BAR; PG8_WAIT_L(0); PG8_MMA(0, 1, At, B1); PG8_BAR;
            PG8_LDA(At, 0, 1); PG8_STAGE(PG8_SA(0, 0), a2, voffA);
            PG8_BAR; PG8_WAIT_L(0); PG8_MMA(1, 0, At, B0); PG8_BAR; PG8_SCHED;
            PG8_STAGE(PG8_SB(0, 1), b2 + hstep, voffB);
            PG8_WAIT_V(6); PG8_BAR; PG8_MMA(1, 1, At, B1); PG8_BAR;
            PG8_LDB(B0, 1, 0); PG8_SCHED; PG8_LDA(At, 1, 0); PG8_STAGE(PG8_SA(0, 1), a2 + hstep, voffA);
            PG8_WAIT_L(8); PG8_BAR; PG8_WAIT_L(0); PG8_MMA(0, 0, At, B0); PG8_BAR; PG8_SCHED;
            PG8_LDB(B1, 1, 1); PG8_STAGE(PG8_SB(1, 0), b3, voffB);
            PG8_BAR; PG8_WAIT_L(0); PG8_MMA(0, 1, At, B1); PG8_BAR;
            PG8_LDA(At, 1, 1); PG8_STAGE(PG8_SA(1, 0), a3, voffA);
            PG8_BAR; PG8_WAIT_L(0); PG8_MMA(1, 0, At, B0); PG8_BAR; PG8_SCHED;
            PG8_STAGE(PG8_SB(1, 1), b3 + hstep, voffB);
            PG8_WAIT_V(6); PG8_BAR; PG8_MMA(1, 1, At, B1); PG8_BAR;
            }
        }
        if constexpr (ALIGN_EPI) { if (wr == 0) PG8_BAR; }
        if constexpr (!Epi::AFTER_DRAIN) { E(acc, cur, wr, wc, fr, fq); S.done(cur); }
        if (!has_next) break;
#pragma unroll
        for (int a = 0; a < 2; ++a)
#pragma unroll
            for (int b = 0; b < 2; ++b)
#pragma unroll
                for (int m = 0; m < 4; ++m)
#pragma unroll
                    for (int n = 0; n < 2; ++n) acc[a][b][m][n] = (f32x4){0.f, 0.f, 0.f, 0.f};
        cur = nxt; cA = nA; cB = nB; ++ui;
        if constexpr (ALIGN_EPI) { if (wr == 1) PG8_BAR; }
    }
    PG8_WAIT_V(0);
    if constexpr (!ALIGN_EPI) { if (wr == 0) PG8_BAR; }
    PG8_BAR;
    if constexpr (Epi::AFTER_DRAIN) { E.fused(acc, cur, wr, wc, fr, fq, lds, wid, lane); S.done(cur); }
#undef PG8_SA
#undef PG8_SB
#undef PG8_STAGE
#undef PG8_LDA
#undef PG8_LDB
#undef PG8_MMA
#undef PG8_WAIT_V
#undef PG8_WAIT_L
#undef PG8_BAR
#undef PG8_SCHED
}
}

namespace pg8 {
__device__ __forceinline__ float fsigmoid(float x) { return __builtin_amdgcn_rcpf(1.0f + __builtin_amdgcn_exp2f(x * -1.44269504089f)); }
__device__ __forceinline__ float bflo(unsigned w) { return __uint_as_float(w << 16); }
__device__ __forceinline__ float bfhi(unsigned w) { return __uint_as_float(w & 0xffff0000u); }
constexpr float RMS_EPS = 1e-6f;

struct EpiSwiglu {
    static constexpr bool PERM = true, AFTER_DRAIN = false;
    bf16_t* O; int ldo; const float* ssq; float invd;
    __device__ __forceinline__ void operator()(const f32x4 (&acc)[2][2][4][2], const Unit& u, int wr, int wc, int fr, int fq) const {
        const int row0 = u.pm * BM + wr * 64 + fr, col0 = u.pn * HALF + wc * 32 + 8 * fq;
#pragma unroll
        for (int ai = 0; ai < 2; ++ai)
#pragma unroll
            for (int m = 0; m < 4; ++m) {
                const int row = row0 + ai * HALF + m * 16;
                const float rs = __builtin_amdgcn_rsqf(ssq[row] * invd + RMS_EPS);
                float h[8];
#pragma unroll
                for (int n = 0; n < 2; ++n)
#pragma unroll
                    for (int i = 0; i < 4; ++i) { const float g = acc[ai][0][m][n][i] * rs, up = acc[ai][1][m][n][i] * rs; h[n * 4 + i] = g * fsigmoid(g) * up; }
                u32x4 w; w.x = cvt_pk_bf16(h[0], h[1]); w.y = cvt_pk_bf16(h[2], h[3]); w.z = cvt_pk_bf16(h[4], h[5]); w.w = cvt_pk_bf16(h[6], h[7]);
                *(u32x4*)(O + (size_t)row * ldo + col0) = w;
            }
    }
};

template <bool BF_BASE> struct EpiResidT {
    static constexpr bool PERM = true, AFTER_DRAIN = false;
    const float* basef; const bf16_t* baseb; float* outf; bf16_t* ob; float* ssq_out; int ldc; float alpha;
    __device__ __forceinline__ void operator()(const f32x4 (&acc)[2][2][4][2], const Unit& u, int wr, int wc, int fr, int fq) const {
        const int row0 = u.pm * BM + wr * 64 + fr, col0 = u.pn * BM + wc * 32 + 8 * fq;
#pragma unroll
        for (int ai = 0; ai < 2; ++ai)
#pragma unroll
            for (int m = 0; m < 4; ++m) {
                const int row = row0 + ai * HALF + m * 16; float s = 0.f;
#pragma unroll
                for (int bj = 0; bj < 2; ++bj) {
                    const size_t off = (size_t)row * ldc + col0 + bj * HALF;
                    f32x4 b0, b1;
                    if constexpr (BF_BASE) { const u32x4 p = *(const u32x4*)(baseb + off); b0 = (f32x4){bflo(p.x), bfhi(p.x), bflo(p.y), bfhi(p.y)}; b1 = (f32x4){bflo(p.z), bfhi(p.z), bflo(p.w), bfhi(p.w)}; }
                    else { b0 = *(const f32x4*)(basef + off); b1 = *(const f32x4*)(basef + off + 4); }
                    const f32x4 v0 = b0 + acc[ai][bj][m][0] * alpha, v1 = b1 + acc[ai][bj][m][1] * alpha;
                    if (outf) { *(f32x4*)(outf + off) = v0; *(f32x4*)(outf + off + 4) = v1; }
                    s += (v0[0] * v0[0] + v0[1] * v0[1]) + (v0[2] * v0[2] + v0[3] * v0[3]) + (v1[0] * v1[0] + v1[1] * v1[1]) + (v1[2] * v1[2] + v1[3] * v1[3]);
                    if (ob) { u32x4 w; w.x = cvt_pk_bf16(v0[0], v0[1]); w.y = cvt_pk_bf16(v0[2], v0[3]); w.z = cvt_pk_bf16(v1[0], v1[1]); w.w = cvt_pk_bf16(v1[2], v1[3]); *(u32x4*)(ob + off) = w; }
                }
                s += __shfl_xor(s, 16); s += __shfl_xor(s, 32);
                if (fq == 0) unsafeAtomicAdd(ssq_out + row, s);
            }
    }
};

struct EpiIn {
    static constexpr bool PERM = true, AFTER_DRAIN = false;
    bf16_t* U; bf16_t* GLU; bf16_t* GATES; const float* bgate; const float* ssq; float invd;
    __device__ __forceinline__ void operator()(const f32x4 (&acc)[2][2][4][2], const Unit& u, int wr, int wc, int fr, int fq) const {
        const int row0 = u.pm * BM + wr * 64 + fr, cl = wc * 32 + 8 * fq;
        if (u.pn >= 12) {
            const int colb = (u.pn - 12) * BM + cl;
            f32x4 bv[2][2];
#pragma unroll
            for (int bj = 0; bj < 2; ++bj)
#pragma unroll
                for (int n = 0; n < 2; ++n) bv[bj][n] = *(const f32x4*)(bgate + colb + bj * HALF + 4 * n);
#pragma unroll
            for (int ai = 0; ai < 2; ++ai)
#pragma unroll
                for (int m = 0; m < 4; ++m) {
                    const int row = row0 + ai * HALF + m * 16;
                    const float rs = __builtin_amdgcn_rsqf(ssq[row] * invd + RMS_EPS);
#pragma unroll
                    for (int bj = 0; bj < 2; ++bj) {
                        float h[8];
#pragma unroll
                        for (int n = 0; n < 2; ++n)
#pragma unroll
                            for (int i = 0; i < 4; ++i) h[n * 4 + i] = fsigmoid(acc[ai][bj][m][n][i] * rs + bv[bj][n][i]);
                        u32x4 w; w.x = cvt_pk_bf16(h[0], h[1]); w.y = cvt_pk_bf16(h[2], h[3]); w.z = cvt_pk_bf16(h[4], h[5]); w.w = cvt_pk_bf16(h[6], h[7]);
                        *(u32x4*)(GATES + (size_t)row * 4096 + colb + bj * HALF) = w;
                    }
                }
        } else if (u.pn >= 4) {
            const int colb = (u.pn - 4) * HALF + cl;
#pragma unroll
            for (int ai = 0; ai < 2; ++ai)
#pragma unroll
                for (int m = 0; m < 4; ++m) {
                    const int row = row0 + ai * HALF + m * 16;
                    const float rs = __builtin_amdgcn_rsqf(ssq[row] * invd + RMS_EPS);
                    float h[8];
#pragma unroll
                    for (int n = 0; n < 2; ++n)
#pragma unroll
                        for (int i = 0; i < 4; ++i) h[n * 4 + i] = (acc[ai][0][m][n][i] * rs) * fsigmoid(acc[ai][1][m][n][i] * rs);
                    u32x4 w; w.x = cvt_pk_bf16(h[0], h[1]); w.y = cvt_pk_bf16(h[2], h[3]); w.z = cvt_pk_bf16(h[4], h[5]); w.w = cvt_pk_bf16(h[6], h[7]);
                    *(u32x4*)(GLU + (size_t)row * 1024 + colb) = w;
                }
        } else {
            const int colb = u.pn * BM + cl;
#pragma unroll
            for (int ai = 0; ai < 2; ++ai)
#pragma unroll
                for (int m = 0; m < 4; ++m) {
                    const int row = row0 + ai * HALF + m * 16;
                    const float rs = __builtin_amdgcn_rsqf(ssq[row] * invd + RMS_EPS);
#pragma unroll
                    for (int bj = 0; bj < 2; ++bj) {
                        const f32x4 v0 = acc[ai][bj][m][0] * rs, v1 = acc[ai][bj][m][1] * rs;
                        u32x4 w; w.x = cvt_pk_bf16(v0[0], v0[1]); w.y = cvt_pk_bf16(v0[2], v0[3]); w.z = cvt_pk_bf16(v1[0], v1[1]); w.w = cvt_pk_bf16(v1[2], v1[3]);
                        *(u32x4*)(U + (size_t)row * 1024 + colb + bj * HALF) = w;
                    }
                }
        }
    }
};

struct EpiGateA {
    static constexpr bool PERM = true, AFTER_DRAIN = false;
    bf16_t* GATES;
    __device__ __forceinline__ void operator()(const f32x4 (&acc)[2][2][4][2], const Unit& u, int wr, int wc, int fr, int fq) const {
        const int row0 = u.pm * BM + wr * 64 + fr, col0 = u.pn * BM + wc * 32 + 8 * fq;
#pragma unroll
        for (int ai = 0; ai < 2; ++ai)
#pragma unroll
            for (int m = 0; m < 4; ++m) {
                const int row = row0 + ai * HALF + m * 16;
#pragma unroll
                for (int bj = 0; bj < 2; ++bj) {
                    bf16_t* p = GATES + (size_t)row * 4096 + col0 + bj * HALF;
                    const u32x4 g = *(const u32x4*)p;
                    const f32x4 a0 = acc[ai][bj][m][0], a1 = acc[ai][bj][m][1];
                    u32x4 w; w.x = cvt_pk_bf16(bflo(g.x) * a0[0], bfhi(g.x) * a0[1]); w.y = cvt_pk_bf16(bflo(g.y) * a0[2], bfhi(g.y) * a0[3]);
                    w.z = cvt_pk_bf16(bflo(g.z) * a1[0], bfhi(g.z) * a1[1]); w.w = cvt_pk_bf16(bflo(g.w) * a1[2], bfhi(g.w) * a1[3]);
                    *(u32x4*)p = w;
                }
            }
    }
};
struct EpiGateB {
    static constexpr bool PERM = true, AFTER_DRAIN = false;
    const bf16_t* GATES; const float* bias; bf16_t* MIX;
    __device__ __forceinline__ void operator()(const f32x4 (&acc)[2][2][4][2], const Unit& u, int wr, int wc, int fr, int fq) const {
        const int row0 = u.pm * BM + wr * 64 + fr, col0 = u.pn * BM + wc * 32 + 8 * fq;
        f32x4 bv[2][2];
#pragma unroll
        for (int bj = 0; bj < 2; ++bj)
#pragma unroll
            for (int n = 0; n < 2; ++n) bv[bj][n] = *(const f32x4*)(bias + col0 + bj * HALF + 4 * n);
#pragma unroll
        for (int ai = 0; ai < 2; ++ai)
#pragma unroll
            for (int m = 0; m < 4; ++m) {
                const int row = row0 + ai * HALF + m * 16;
#pragma unroll
                for (int bj = 0; bj < 2; ++bj) {
                    const bf16_t* p = GATES + (size_t)row * 4096 + col0 + bj * HALF;
                    const u32x4 ta = *(const u32x4*)p, g = *(const u32x4*)(p + 2048);
                    const f32x4 a0 = acc[ai][bj][m][0] + bv[bj][0], a1 = acc[ai][bj][m][1] + bv[bj][1];
                    u32x4 w; w.x = cvt_pk_bf16(bflo(ta.x) + bflo(g.x) * a0[0], bfhi(ta.x) + bfhi(g.x) * a0[1]); w.y = cvt_pk_bf16(bflo(ta.y) + bflo(g.y) * a0[2], bfhi(ta.y) + bfhi(g.y) * a0[3]);
                    w.z = cvt_pk_bf16(bflo(ta.z) + bflo(g.z) * a1[0], bfhi(ta.z) + bfhi(g.z) * a1[1]); w.w = cvt_pk_bf16(bflo(ta.w) + bflo(g.w) * a1[2], bfhi(ta.w) + bfhi(g.w) * a1[3]);
                    *(u32x4*)(MIX + (size_t)row * 2048 + col0 + bj * HALF) = w;
                }
            }
    }
};
struct PairOrder {
    StaticOrder S;
    __device__ bool next(int i, Unit& u) const { if (!S.next(i >> 1, u)) return false; if (i & 1) { u.pm += S.nM; u.pn += S.nN; } return true; }
    __device__ __forceinline__ void a_ready(const Unit&) const {}
    __device__ __forceinline__ void done(const Unit&) const {}
};
struct EpiGateAB {
    static constexpr bool PERM = true, AFTER_DRAIN = false;
    EpiGateA a; EpiGateB b; int nM, nN;
    __device__ __forceinline__ void operator()(const f32x4 (&acc)[2][2][4][2], const Unit& u, int wr, int wc, int fr, int fq) const {
        if (u.pm < nM) a(acc, u, wr, wc, fr, fq);
        else { Unit v; v.pm = u.pm - nM; v.pn = u.pn - nN; b(acc, v, wr, wc, fr, fq); }
    }
};
struct EpiFinal {
    static constexpr bool PERM = true, AFTER_DRAIN = true;
    const bf16_t* base; float* out; float* ssq; unsigned* cnt; const float* gain; int ldc; float alpha, invd; unsigned ntn;
    __device__ __forceinline__ void fused(f32x4 (&acc)[2][2][4][2], const Unit& u, int wr, int wc, int fr, int fq, PG8_LAS unsigned char* lds, int wid, int lane) const {
        const int row0 = u.pm * BM + wr * 64 + fr, col0 = u.pn * BM + wc * 32 + 8 * fq;
#pragma unroll
        for (int ai = 0; ai < 2; ++ai)
#pragma unroll
            for (int m = 0; m < 4; ++m) {
                const int row = row0 + ai * HALF + m * 16; float s = 0.f;
#pragma unroll
                for (int bj = 0; bj < 2; ++bj) {
                    const size_t off = (size_t)row * ldc + col0 + bj * HALF;
                    const u32x4 p = *(const u32x4*)(base + off);
                    const f32x4 b0 = (f32x4){bflo(p.x), bfhi(p.x), bflo(p.y), bfhi(p.y)}, b1 = (f32x4){bflo(p.z), bfhi(p.z), bflo(p.w), bfhi(p.w)};
                    const f32x4 v0 = b0 + acc[ai][bj][m][0] * alpha, v1 = b1 + acc[ai][bj][m][1] * alpha;
                    acc[ai][bj][m][0] = v0; acc[ai][bj][m][1] = v1;
                    s += (v0[0] * v0[0] + v0[1] * v0[1]) + (v0[2] * v0[2] + v0[3] * v0[3]) + (v1[0] * v1[0] + v1[1] * v1[1]) + (v1[2] * v1[2] + v1[3] * v1[3]);
                }
                s += __shfl_xor(s, 16); s += __shfl_xor(s, 32);
                if (fq == 0) unsafeAtomicAdd(ssq + row, s);
            }
        asm volatile("s_waitcnt vmcnt(0)" ::: "memory");
        __syncthreads();
        if (threadIdx.x == 0) {
            unsigned* c = cnt + 64 * u.pm;
            __builtin_amdgcn_fence(__ATOMIC_RELEASE, "agent");
            __hip_atomic_fetch_add(c, 1u, __ATOMIC_RELAXED, __HIP_MEMORY_SCOPE_AGENT);
            unsigned sp = 0;
            while (__hip_atomic_load(c, __ATOMIC_RELAXED, __HIP_MEMORY_SCOPE_AGENT) < ntn) { __builtin_amdgcn_s_sleep(2); if (++sp > (1u << 22)) break; }
            __builtin_amdgcn_fence(__ATOMIC_ACQUIRE, "agent");
        }
        __syncthreads();
        f32x4 gv[2][2];
#pragma unroll
        for (int bj = 0; bj < 2; ++bj)
#pragma unroll
            for (int n = 0; n < 2; ++n) gv[bj][n] = *(const f32x4*)(gain + col0 + bj * HALF + 4 * n);
#pragma unroll
        for (int ai = 0; ai < 2; ++ai)
#pragma unroll
            for (int m = 0; m < 4; ++m) {
                const int row = row0 + ai * HALF + m * 16;
                const float rs = __builtin_amdgcn_rsqf(__hip_atomic_load(ssq + row, __ATOMIC_RELAXED, __HIP_MEMORY_SCOPE_AGENT) * invd + RMS_EPS);
#pragma unroll
                for (int bj = 0; bj < 2; ++bj) {
                    const size_t off = (size_t)row * ldc + col0 + bj * HALF;
                    __builtin_nontemporal_store(acc[ai][bj][m][0] * rs * gv[bj][0], (f32x4*)(out + off));
                    __builtin_nontemporal_store(acc[ai][bj][m][1] * rs * gv[bj][1], (f32x4*)(out + off + 4));
                }
            }
    }
};
}

#ifndef MK_N_LAUNCHES
#define MK_N_LAUNCHES 1
#endif
#ifndef MK_SP2
#define MK_SP2 true
#endif
constexpr int NWAVES = 8, NTHREADS = NWAVES * 64;
constexpr int NPHASES = 11;
constexpr int BATCH = 2, T = 4096, D = 2048, M = BATCH * T, FF = 5632, DP = 1024, DC = 1024, DIN = 7168, CONVW = 31;

constexpr size_t MiB = 1u << 20;
constexpr size_t WS_CTL = 0, CTL_ZERO_BYTES = 1 * MiB;
constexpr size_t SSQ0_OFF = 65536, SSQ1_OFF = SSQ0_OFF + 32768, SSQ2_OFF = SSQ1_OFF + 32768, SSQ3_OFF = SSQ2_OFF + 32768;
constexpr size_t WS_W1T = 1 * MiB, WS_WD1T = 45 * MiB, WS_WINT = 67 * MiB, WS_WPOOLT = 95 * MiB, WS_WCONVT = 99 * MiB, WS_WOUTT = 103 * MiB, WS_W2T = 111 * MiB, WS_WD2T = 155 * MiB;
constexpr size_t WS_XB = 177 * MiB, WS_ACT = 209 * MiB, WS_GATES = 297 * MiB, WS_END = 361 * MiB;
constexpr size_t WS_U = WS_ACT, WS_GLU = WS_ACT + 16 * MiB, WS_P = WS_ACT + 32 * MiB, WS_Y = WS_ACT + 48 * MiB, WS_MIX = WS_ACT;
static_assert(WS_W1T + (size_t)2 * FF * D * 2 <= WS_WD1T && WS_WD1T + (size_t)D * FF * 2 <= WS_WINT && WS_WINT + (size_t)DIN * D * 2 <= WS_WPOOLT && WS_WOUTT + (size_t)D * D * 2 <= WS_W2T, "ws map");
static_assert(WS_W2T + (size_t)2 * FF * D * 2 <= WS_WD2T && WS_WD2T + (size_t)D * FF * 2 <= WS_XB && WS_XB + (size_t)M * D * 2 <= WS_ACT && WS_ACT + (size_t)M * FF * 2 <= WS_GATES && WS_GATES + (size_t)M * 4096 * 2 <= WS_END, "ws map");

constexpr int RING_BYTES = 131072, LDS_BYTES = 147456;
constexpr int MISC_OFF = LDS_BYTES - 64;
constexpr size_t CNT_OFF = 32768;
constexpr size_t TRCTR_OFF = 49152;
constexpr size_t DWB_OFF = 262144;
constexpr size_t BAR_OFF = 16384;
constexpr int P0_SCR = 16640;

#define LAS __attribute__((address_space(3)))
typedef unsigned short bf16;
typedef unsigned v4u __attribute__((ext_vector_type(4)));
typedef float f32x4 __attribute__((ext_vector_type(4)));
#define LDS_WAIT() asm volatile("s_waitcnt lgkmcnt(0)" ::: "memory")
using pg8::cvt_pk_bf16; using pg8::bflo; using pg8::bfhi; using pg8::fsigmoid;

__device__ __forceinline__ float wave_sum(float v) {
#pragma unroll
    for (int o = 1; o < 64; o <<= 1) v += __shfl_xor(v, o);
    return v;
}
__device__ __forceinline__ int map_row(int mode, int n0) {
    if (mode == 0) return n0;
    if (mode == 1) return ((n0 >> 7) << 8) + (n0 & 127);
    if (mode == 2) return ((n0 >> 7) << 8) + 128 + (n0 & 127);
    if (n0 < 1024 || n0 >= 3072) return n0;
    if (n0 < 2048) { const int j = n0 - 1024; return 1024 + ((j >> 7) << 8) + (j & 127); }
    const int j = n0 - 2048; return 1024 + ((j >> 7) << 8) + 128 + (j & 127);
}
__device__ __forceinline__ void p0_tr_item(const float* __restrict__ W, int K, int N, const float* __restrict__ gain, bf16* __restrict__ WT, int mode, int item, int lane) {
    const int nblk = N >> 7, kb = item / nblk, nb = item - kb * nblk, k0 = (kb << 6) + ((lane >> 5) << 5), n0 = (nb << 7) + ((lane & 31) << 2);
    const float* src = W + (size_t)k0 * N + n0;
    f32x4 v[32];
#pragma unroll
    for (int i = 0; i < 32; ++i) v[i] = __builtin_nontemporal_load((const f32x4*)(src + (size_t)i * N));
    if (gain) {
#pragma unroll
        for (int i = 0; i < 32; ++i) v[i] *= gain[k0 + i];
    }
    bf16* dst = WT + (size_t)map_row(mode, n0) * K + k0;
#pragma unroll
    for (int j = 0; j < 4; ++j)
#pragma unroll
        for (int q = 0; q < 4; ++q) {
            v4u o; o.x = cvt_pk_bf16(v[8 * q + 0][j], v[8 * q + 1][j]); o.y = cvt_pk_bf16(v[8 * q + 2][j], v[8 * q + 3][j]); o.z = cvt_pk_bf16(v[8 * q + 4][j], v[8 * q + 5][j]); o.w = cvt_pk_bf16(v[8 * q + 6][j], v[8 * q + 7][j]);
            *(v4u*)(dst + (size_t)j * K + 8 * q) = o;
        }
}
__device__ __forceinline__ void p0_fold_item(const float* __restrict__ wg, const float* __restrict__ scale, const float* __restrict__ wp, bf16* __restrict__ WPT, int item, LAS float* scr, int lane) {
    const int nb = item & 31, cb = (item >> 5) & 15, g = item >> 9, n0 = nb << 6, c0 = cb << 4;
#pragma unroll
    for (int ci = 0; ci < 16; ++ci) {
        const f32x4 a = *(const f32x4*)(wg + ((size_t)(g * 256 + c0 + ci)) * 256 + lane * 4), s = *(const f32x4*)(scale + g * 256 + lane * 4);
        *(LAS f32x4*)(scr + ci * 256 + lane * 4) = a * s;
    }
    LDS_WAIT(); asm volatile("" ::: "memory");
    float acc[16];
#pragma unroll
    for (int ci = 0; ci < 16; ++ci) acc[ci] = 0.f;
    const float* bp = wp + (size_t)(g * 256) * D + n0 + lane;
    for (int d = 0; d < 256; d += 4) {
        const float b0 = bp[(size_t)(d + 0) * D], b1 = bp[(size_t)(d + 1) * D], b2 = bp[(size_t)(d + 2) * D], b3 = bp[(size_t)(d + 3) * D];
#pragma unroll
        for (int ci = 0; ci < 16; ++ci) { const f32x4 a = *(const LAS f32x4*)(scr + ci * 256 + d); acc[ci] += (a[0] * b0 + a[1] * b1) + (a[2] * b2 + a[3] * b3); }
    }
    v4u o0, o1;
    o0.x = cvt_pk_bf16(acc[0], acc[1]); o0.y = cvt_pk_bf16(acc[2], acc[3]); o0.z = cvt_pk_bf16(acc[4], acc[5]); o0.w = cvt_pk_bf16(acc[6], acc[7]);
    o1.x = cvt_pk_bf16(acc[8], acc[9]); o1.y = cvt_pk_bf16(acc[10], acc[11]); o1.z = cvt_pk_bf16(acc[12], acc[13]); o1.w = cvt_pk_bf16(acc[14], acc[15]);
    bf16* dst = WPT + (size_t)(n0 + lane) * DP + g * 256 + c0;
    *(v4u*)dst = o0; *(v4u*)(dst + 8) = o1;
    LDS_WAIT(); asm volatile("" ::: "memory");
}
__device__ __forceinline__ void unpack8(const v4u w, float (&f)[8]) { f[0] = bflo(w.x); f[1] = bfhi(w.x); f[2] = bflo(w.y); f[3] = bfhi(w.y); f[4] = bflo(w.z); f[5] = bfhi(w.z); f[6] = bflo(w.w); f[7] = bfhi(w.w); }
__device__ __forceinline__ v4u pack8(const float (&f)[8]) { v4u o; o.x = cvt_pk_bf16(f[0], f[1]); o.y = cvt_pk_bf16(f[2], f[3]); o.z = cvt_pk_bf16(f[4], f[5]); o.w = cvt_pk_bf16(f[6], f[7]); return o; }

template <int HMAX>
__device__ __forceinline__ void p4_pool_half(const bf16* __restrict__ ucol, bf16* __restrict__ pcol, int t0, int h) {
    float s[4][8], u[4][8];
#pragma unroll
    for (int r = 0; r < 4; ++r)
#pragma unroll
        for (int i = 0; i < 8; ++i) s[r][i] = 0.f;
#pragma unroll
    for (int jd = -HMAX; jd < 3 + HMAX; ++jd) {
        const int tt = t0 + jd, ttc = tt < 0 ? 0 : (tt >= T ? T - 1 : tt);
        const unsigned msk = (tt == ttc) ? 0xffffffffu : 0u;
        v4u w = *(const v4u*)(ucol + (size_t)ttc * DP);
        w.x &= msk; w.y &= msk; w.z &= msk; w.w &= msk;
        float f[8]; unpack8(w, f);
#pragma unroll
        for (int r = 0; r < 4; ++r) {
            const int rel = jd - r;
            if (rel >= -HMAX && rel < HMAX) {
                const float mk = (rel >= -h && rel < h) ? 1.f : 0.f;
#pragma unroll
                for (int i = 0; i < 8; ++i) s[r][i] += f[i] * mk;
            }
            if (rel == 0) {
#pragma unroll
                for (int i = 0; i < 8; ++i) u[r][i] = f[i];
            }
        }
    }
#pragma unroll
    for (int r = 0; r < 4; ++r) {
        const int t = t0 + r, lo = t - h < 0 ? 0 : t - h, hi = t + h > T ? T : t + h;
        const float inv = 1.0f / (float)(hi - lo);
        float o[8];
#pragma unroll
        for (int i = 0; i < 8; ++i) o[i] = s[r][i] * inv - u[r][i];
        *(v4u*)(pcol + (size_t)t * DP) = pack8(o);
    }
}
__device__ __forceinline__ void p4_pool_item(const bf16* __restrict__ U, bf16* __restrict__ P, int item, int lane) {
    const int r0 = item * 4, b = r0 / T, t0 = r0 - b * T;
    const bf16* ub = U + (size_t)(b * T) * DP; bf16* pb = P + (size_t)(b * T) * DP;
    p4_pool_half<2>(ub + lane * 8, pb + lane * 8, t0, 1 << (lane >> 5));
    p4_pool_half<8>(ub + 512 + lane * 8, pb + 512 + lane * 8, t0, 4 << (lane >> 5));
}
__device__ __forceinline__ const char* uniform_ptr(const void* p) {
    const unsigned long long v = (unsigned long long)p;
    const unsigned lo = __builtin_amdgcn_readfirstlane((unsigned)v), hi = __builtin_amdgcn_readfirstlane((unsigned)(v >> 32));
    return (const char*)(((unsigned long long)hi << 32) | lo);
}
constexpr int CONV_GS = 12, CONV_NG = (CONVW + 3 + CONV_GS) / CONV_GS;
struct ConvGrp { v4u g[CONV_GS], w[CONV_GS]; };
__device__ __forceinline__ void p4_conv_load(ConvGrp& G, const bf16* __restrict__ gbase, const bf16* __restrict__ wbase, int coff, int t0, int jj) {
#pragma unroll
    for (int u = 0; u < CONV_GS; ++u) {
        const int j = jj * CONV_GS + u, jc = j < CONVW ? j : CONVW - 1;
        G.w[u] = *(const v4u*)(uniform_ptr(wbase + jc * DC) + (unsigned)coff * 2u);
        const int t = t0 - 15 + j, tc = t < 0 ? 0 : (t >= T ? T - 1 : t);
        G.g[u] = *(const v4u*)(uniform_ptr(gbase + (size_t)tc * DC) + (unsigned)coff * 2u);
    }
}
__device__ __forceinline__ void p4_conv_half(const bf16* __restrict__ gbase, const bf16* __restrict__ wbase, int coff, int t0, float (&acc)[4][8]) {
    float w[4][8];
#pragma unroll
    for (int u = 0; u < 4; ++u)
#pragma unroll
        for (int i = 0; i < 8; ++i) w[u][i] = 0.f;
#pragma unroll 1
    for (int jj = 0; jj < CONV_NG; ++jj) {
        ConvGrp cur;
        p4_conv_load(cur, gbase, wbase, coff, t0, jj);
#pragma unroll
        for (int u = 0; u < CONV_GS; ++u) {
            const int j = jj * CONV_GS + u, t = t0 - 15 + j;
            const float wm = j < CONVW ? 1.f : 0.f;
            const unsigned msk = (t >= 0 && t < T) ? 0xffffffffu : 0u;
            { float wf[8]; unpack8(cur.w[u], wf);
#pragma unroll
              for (int i = 0; i < 8; ++i) w[u & 3][i] = wf[i] * wm; }
            v4u ga = cur.g[u]; ga.x &= msk; ga.y &= msk; ga.z &= msk; ga.w &= msk;
            float g[8]; unpack8(ga, g);
#pragma unroll
            for (int r = 0; r < 4; ++r)
#pragma unroll
                for (int i = 0; i < 8; ++i) acc[r][i] += w[(u - r) & 3][i] * g[i];
        }
    }
}
__device__ __forceinline__ void p4_conv_item(const bf16* __restrict__ GLU, const bf16* __restrict__ dww, const float* __restrict__ dwb, const float* __restrict__ lng, const float* __restrict__ lnb,
                                             bf16* __restrict__ Y, int item, int lane) {
    const int r0 = item * 4, b = r0 / T, t0 = r0 - b * T;
    const int cA = lane * 8, cB = 512 + lane * 8;
    const bf16* gb = GLU + (size_t)(b * T) * DC;
    float accA[4][8], accB[4][8];
    asm volatile("" ::: "memory");
    {
        const f32x4 b0 = *(const f32x4*)(dwb + cA), b1 = *(const f32x4*)(dwb + cA + 4), b2 = *(const f32x4*)(dwb + cB), b3 = *(const f32x4*)(dwb + cB + 4);
#pragma unroll
        for (int r = 0; r < 4; ++r)
#pragma unroll
            for (int i = 0; i < 4; ++i) { accA[r][i] = b0[i]; accA[r][4 + i] = b1[i]; accB[r][i] = b2[i]; accB[r][4 + i] = b3[i]; }
    }
    p4_conv_half(gb, dww, cA, t0, accA);
    __builtin_amdgcn_sched_barrier(0);
    p4_conv_half(gb, dww, cB, t0, accB);
    f32x4 lg[4], lb[4];
    asm volatile("" ::: "memory");
    lg[0] = *(const f32x4*)(lng + cA); lg[1] = *(const f32x4*)(lng + cA + 4); lg[2] = *(const f32x4*)(lng + cB); lg[3] = *(const f32x4*)(lng + cB + 4);
    lb[0] = *(const f32x4*)(lnb + cA); lb[1] = *(const f32x4*)(lnb + cA + 4); lb[2] = *(const f32x4*)(lnb + cB); lb[3] = *(const f32x4*)(lnb + cB + 4);
#pragma unroll
    for (int r = 0; r < 4; ++r) {
        float s = 0.f;
#pragma unroll
        for (int i = 0; i < 8; ++i) s += accA[r][i] + accB[r][i];
        const float mu = wave_sum(s) * (1.0f / DC);
        float q = 0.f;
#pragma unroll
        for (int i = 0; i < 8; ++i) { accA[r][i] -= mu; accB[r][i] -= mu; q += accA[r][i] * accA[r][i] + accB[r][i] * accB[r][i]; }
        const float rstd = __builtin_amdgcn_rsqf(wave_sum(q) * (1.0f / DC) + pg8::RMS_EPS);
        float oa[8], ob[8];
#pragma unroll
        for (int i = 0; i < 8; ++i) {
            const float ya = accA[r][i] * rstd * lg[i >> 2][i & 3] + lb[i >> 2][i & 3], yb = accB[r][i] * rstd * lg[2 + (i >> 2)][i & 3] + lb[2 + (i >> 2)][i & 3];
            oa[i] = ya * fsigmoid(ya); ob[i] = yb * fsigmoid(yb);
        }
        bf16* yr = Y + (size_t)(r0 + r) * DC;
        *(v4u*)(yr + cA) = pack8(oa); *(v4u*)(yr + cB) = pack8(ob);
    }
}

#define RLX_AGENT __ATOMIC_RELAXED, __HIP_MEMORY_SCOPE_AGENT
#define XB_TMO      128
#define XB_XCNT(j)  (256  + 64 * (j))
#define XB_XSUB(j)  (1280 + 64 * (j))
#define XB_XGEN(j)  (2304 + 64 * (j))
#define XB_TOP      3328
#define XB_TOPGEN   3392
#define XCD_BAR_WORDS 3456
#define XB_SPIN_CAP (1u << 18)

__device__ __forceinline__ unsigned xb_ld(unsigned* p)              { return __hip_atomic_load(p, __ATOMIC_RELAXED, __HIP_MEMORY_SCOPE_AGENT); }
__device__ __forceinline__ unsigned xb_add(unsigned* p, unsigned v) { return __hip_atomic_fetch_add(p, v, __ATOMIC_RELAXED, __HIP_MEMORY_SCOPE_AGENT); }
__device__ __forceinline__ unsigned xb_xcc_id() { return (unsigned)__builtin_amdgcn_s_getreg((3 << 11) | 20) & 0xFu; }
#define XB_SPIN(cond, bar) do { unsigned _sp = 0; while (cond) { __builtin_amdgcn_s_sleep(1); \
    if ((++_sp & 255u) == 0u) { if (xb_ld(&(bar)[XB_TMO])) break; if (_sp > XB_SPIN_CAP) { atomicAdd(&(bar)[XB_TMO], 1u); break; } } } } while (0)

struct XcdBarrier {
    unsigned* bar; unsigned x;
    volatile LAS unsigned* st;
};

__device__ __forceinline__ XcdBarrier xcd_barrier_post(unsigned* bar, volatile LAS unsigned* st) {
    XcdBarrier b; b.bar = bar; b.x = xb_xcc_id(); b.st = st;
    if (threadIdx.x == 0) (void)xb_add(&bar[XB_XCNT(b.x)], 1u);
    return b;
}
__device__ __forceinline__ void xcd_barrier_complete(unsigned* bar, unsigned x, unsigned& nloc, unsigned& nx) {
    const unsigned G = gridDim.x * gridDim.y * gridDim.z;
    unsigned sum, cnt, mine, sp = 0u;
    for (;;) {
        sum = 0u; cnt = 0u; mine = 0u;
#pragma unroll
        for (unsigned j = 0; j < 16; ++j) { const unsigned c = xb_ld(&bar[XB_XCNT(j)]); sum += c; cnt += (c > 0u) ? 1u : 0u; mine = (j == x) ? c : mine; }
        if (sum == G) break;
        __builtin_amdgcn_s_sleep(1);
        if ((++sp & 255u) == 0u) { if (xb_ld(&bar[XB_TMO])) break; if (sp > XB_SPIN_CAP) { atomicAdd(&bar[XB_TMO], 1u); break; } }
    }
    nloc = mine > 0u ? mine : 1u; nx = cnt > 0u ? cnt : 1u;
}

__device__ __forceinline__ void xcd_barrier(const XcdBarrier& b) {
    asm volatile("s_waitcnt vmcnt(0)" ::: "memory");
    __syncthreads();
    if (threadIdx.x == 0) {
        unsigned* bar = b.bar;
        __builtin_amdgcn_s_waitcnt(0);
        unsigned nloc = b.st[0], nx = b.st[1];
        if (nloc == 0u) { xcd_barrier_complete(bar, b.x, nloc, nx); b.st[0] = nloc; b.st[1] = nx; }
        const unsigned old = xb_add(&bar[XB_XSUB(b.x)], 1u);
        const unsigned gen = old / nloc;
        if (old + 1u == (gen + 1u) * nloc) {
            __builtin_amdgcn_fence(__ATOMIC_RELEASE, "agent");
            asm volatile("s_waitcnt vmcnt(0)" ::: "memory");
            const unsigned og = xb_add(&bar[XB_TOP], 1u);
            const unsigned tg = og / nx;
            if (og + 1u == (tg + 1u) * nx) xb_add(&bar[XB_TOPGEN], 1u);
            else XB_SPIN(xb_ld(&bar[XB_TOPGEN]) == tg, bar);
            __builtin_amdgcn_fence(__ATOMIC_ACQUIRE, "agent");
            xb_add(&bar[XB_XGEN(b.x)], 1u);
            asm volatile("s_waitcnt vmcnt(0)" ::: "memory");
        } else {
            XB_SPIN(xb_ld(&bar[XB_XGEN(b.x)]) == gen, bar);
            __builtin_amdgcn_fence(__ATOMIC_ACQUIRE, "agent");
            asm volatile("s_waitcnt vmcnt(0)" ::: "memory");
        }
    }
    __syncthreads();
}
struct Args { const float* in[23]; float* out; unsigned char* ws; int ph_lo, ph_hi; };

constexpr int I_GU = (D / 64) * (FF / 128), I_DN = (FF / 64) * (D / 128), I_IN = (D / 64) * (DIN / 128), I_CV = (DC / 64) * (D / 128), I_WO = (D / 64) * (D / 128), I_FOLD = 4 * 16 * 32;
constexpr int TR_W1U = I_GU, TR_WD1 = 2 * I_GU, TR_WIN = TR_WD1 + I_DN, TR_CV = TR_WIN + I_IN, TR_WO = TR_CV + I_CV, TR_W2G = TR_WO + I_WO, TR_W2U = TR_W2G + I_GU, TR_WD2 = TR_W2U + I_GU, TR_END = TR_WD2 + I_DN;
#ifndef MK_TR_C0
#define MK_TR_C0 TR_WD1
#endif
#ifndef MK_TR_C1
#define MK_TR_C1 TR_W2G
#endif
#ifndef MK_TR_C2
#define MK_TR_C2 TR_WD2
#endif
constexpr int TR_C0 = MK_TR_C0, TR_C1 = MK_TR_C1, TR_C2 = MK_TR_C2;
static_assert(TR_C0 >= TR_WD1 && TR_C1 >= TR_CV && TR_C1 >= TR_C0 && TR_C2 >= TR_C1, "conversion segments follow the phases' dependencies");
__device__ __forceinline__ void tr_run(const Args& args, int lo, int hi, int worker, int nworkers, int lane) {
    unsigned char* ws = args.ws;
    for (int g = lo + worker; g < hi; g += nworkers) {
        if (g < TR_W1U)      p0_tr_item(args.in[2],  D,  FF,  args.in[1],  (bf16*)(ws + WS_W1T),    1, g,          lane);
        else if (g < TR_WD1) p0_tr_item(args.in[3],  D,  FF,  args.in[1],  (bf16*)(ws + WS_W1T),    2, g - TR_W1U, lane);
        else if (g < TR_WIN) p0_tr_item(args.in[4],  FF, D,   nullptr,     (bf16*)(ws + WS_WD1T),   0, g - TR_WD1, lane);
        else if (g < TR_CV)  p0_tr_item(args.in[6],  D,  DIN, args.in[5],  (bf16*)(ws + WS_WINT),   3, g - TR_WIN, lane);
        else if (g < TR_WO)  p0_tr_item(args.in[15], DC, D,   nullptr,     (bf16*)(ws + WS_WCONVT), 0, g - TR_CV,  lane);
        else if (g < TR_W2G) p0_tr_item(args.in[17], D,  D,   nullptr,     (bf16*)(ws + WS_WOUTT),  0, g - TR_WO,  lane);
        else if (g < TR_W2U) p0_tr_item(args.in[19], D,  FF,  args.in[18], (bf16*)(ws + WS_W2T),    1, g - TR_W2G, lane);
        else if (g < TR_WD2) p0_tr_item(args.in[20], D,  FF,  args.in[18], (bf16*)(ws + WS_W2T),    2, g - TR_W2U, lane);
        else                 p0_tr_item(args.in[21], FF, D,   nullptr,     (bf16*)(ws + WS_WD2T),   0, g - TR_WD2, lane);
    }
}
__device__ __forceinline__ void tr_run_dyn(const Args& args, int lo, int hi, unsigned* ctr, int lane) {
    unsigned char* ws = args.ws;
    for (;;) {
        int g = 0;
        if (lane == 0) g = lo + (int)__hip_atomic_fetch_add(ctr, 1u, __ATOMIC_RELAXED, __HIP_MEMORY_SCOPE_AGENT);
        g = __builtin_amdgcn_readfirstlane(g);
        if (g >= hi) break;
        if (g < TR_W1U)      p0_tr_item(args.in[2],  D,  FF,  args.in[1],  (bf16*)(ws + WS_W1T),    1, g,          lane);
        else if (g < TR_WD1) p0_tr_item(args.in[3],  D,  FF,  args.in[1],  (bf16*)(ws + WS_W1T),    2, g - TR_W1U, lane);
        else if (g < TR_WIN) p0_tr_item(args.in[4],  FF, D,   nullptr,     (bf16*)(ws + WS_WD1T),   0, g - TR_WD1, lane);
        else if (g < TR_CV)  p0_tr_item(args.in[6],  D,  DIN, args.in[5],  (bf16*)(ws + WS_WINT),   3, g - TR_WIN, lane);
        else if (g < TR_WO)  p0_tr_item(args.in[15], DC, D,   nullptr,     (bf16*)(ws + WS_WCONVT), 0, g - TR_CV,  lane);
        else if (g < TR_W2G) p0_tr_item(args.in[17], D,  D,   nullptr,     (bf16*)(ws + WS_WOUTT),  0, g - TR_WO,  lane);
        else if (g < TR_W2U) p0_tr_item(args.in[19], D,  FF,  args.in[18], (bf16*)(ws + WS_W2T),    1, g - TR_W2G, lane);
        else if (g < TR_WD2) p0_tr_item(args.in[20], D,  FF,  args.in[18], (bf16*)(ws + WS_W2T),    2, g - TR_W2U, lane);
        else                 p0_tr_item(args.in[21], FF, D,   nullptr,     (bf16*)(ws + WS_WD2T),   0, g - TR_WD2, lane);
    }
}
__device__ __forceinline__ bool tail_worker(int ntiles, int G, int bid, int wave, int& worker, int& nworkers) {
    const int rounds = (ntiles + G - 1) / G, last = ntiles - (rounds - 1) * G;
    if (last == G) { worker = bid * NWAVES + wave; nworkers = G * NWAVES; return true; }
    if (bid < last) return false;
    worker = (bid - last) * NWAVES + wave; nworkers = (G - last) * NWAVES; return true;
}

__global__ void __launch_bounds__(NTHREADS, 2) mk_fwd(Args args) {
    extern __shared__ __attribute__((aligned(16))) unsigned char lds_raw[];
    LAS unsigned char* lds = (LAS unsigned char*)lds_raw;
    cg::grid_group grid = cg::this_grid();
    const int tid = threadIdx.x, lane = tid & 63, wave = __builtin_amdgcn_readfirstlane(tid >> 6);
    const int G = gridDim.x, gw = blockIdx.x * NWAVES + wave, NGW = G * NWAVES;
    unsigned char* ws = args.ws;
    const float* x = args.in[0];
    float* out = args.out;
    float* ssq0 = (float*)(ws + SSQ0_OFF); float* ssq1 = (float*)(ws + SSQ1_OFF); float* ssq2 = (float*)(ws + SSQ2_OFF); float* ssq3 = (float*)(ws + SSQ3_OFF);
    bf16* W1T = (bf16*)(ws + WS_W1T); bf16* WD1T = (bf16*)(ws + WS_WD1T); bf16* WINT = (bf16*)(ws + WS_WINT); bf16* WPOOLT = (bf16*)(ws + WS_WPOOLT); bf16* WCONVT = (bf16*)(ws + WS_WCONVT);
    bf16* WOUTT = (bf16*)(ws + WS_WOUTT); bf16* W2T = (bf16*)(ws + WS_W2T); bf16* WD2T = (bf16*)(ws + WS_WD2T);
    bf16* XB = (bf16*)(ws + WS_XB); bf16* ACT = (bf16*)(ws + WS_ACT); bf16* GATES = (bf16*)(ws + WS_GATES);
    bf16* UB = (bf16*)(ws + WS_U); bf16* GLUB = (bf16*)(ws + WS_GLU); bf16* PB = (bf16*)(ws + WS_P); bf16* YB = (bf16*)(ws + WS_Y); bf16* MIX = (bf16*)(ws + WS_MIX);
    const int lo = args.ph_lo, hi = args.ph_hi;
    if (lo < 0) grid.sync();
    volatile LAS unsigned* MISC = (volatile LAS unsigned*)(lds + MISC_OFF);
    if (tid < 16) MISC[tid] = 0u;
    __syncthreads();
    XcdBarrier bar = xcd_barrier_post((unsigned*)(ws + BAR_OFF), MISC + 8);
#ifndef MK_PHM
#define MK_PHM 0xffffu
#endif
#define IN(k) (((MK_PHM >> (k)) & 1u) && lo <= (k) && (k) < hi)
#ifndef MK_REP
#define MK_REP 0u
#endif
#define REPS(k) (1 + (int)((MK_REP >> (k)) & 1u))
#define SEAM(k) do { if (IN(k) && IN((k) + 1)) xcd_barrier(bar); } while (0)
    constexpr float INVD = 1.0f / D;

    if (IN(0)) {
        LAS float* scr = (LAS float*)(lds + wave * P0_SCR);
        tr_run(args, 0, TR_C0, gw, NGW, lane);
        for (int it = gw; it < I_FOLD; it += NGW) p0_fold_item(args.in[8], args.in[9], args.in[10], WPOOLT, it, scr, lane);
        for (int i = gw * 64 + lane; i < CONVW * DC / 2; i += NGW * 64) ((unsigned*)(ws + DWB_OFF))[i] = cvt_pk_bf16(args.in[11][2 * i], args.in[11][2 * i + 1]);
        for (int m = gw; m < M; m += NGW) {
            const f32x4* xr = (const f32x4*)(x + (size_t)m * D); float s = 0.f;
#pragma unroll
            for (int j = 0; j < 4; ++j) {
                const f32x4 a = __builtin_nontemporal_load(xr + j * 128 + lane * 2), b = __builtin_nontemporal_load(xr + j * 128 + lane * 2 + 1);
                s += (a[0] * a[0] + a[1] * a[1]) + (a[2] * a[2] + a[3] * a[3]) + (b[0] * b[0] + b[1] * b[1]) + (b[2] * b[2] + b[3] * b[3]);
                v4u o; o.x = cvt_pk_bf16(a[0], a[1]); o.y = cvt_pk_bf16(a[2], a[3]); o.z = cvt_pk_bf16(b[0], b[1]); o.w = cvt_pk_bf16(b[2], b[3]);
                *(v4u*)(XB + (size_t)m * D + j * 512 + lane * 8) = o;
            }
            s = wave_sum(s);
            if (lane == 0) ssq0[m] = s;
        }
        __syncthreads();
    }
    SEAM(0);
    if (IN(1)) {
        pg8::Gemm g{XB, W1T, M, 2 * FF, D}; pg8::StaticOrder S; S.init(M, 2 * FF, G, (int)blockIdx.x);
        pg8::EpiSwiglu E{ACT, FF, ssq0, INVD};
        pg8::gemm_phase<pg8::EpiSwiglu, pg8::StaticOrder, true, MK_SP2>(lds, g, S, E);
        { int worker, nworkers; if (tail_worker((M / 256) * (2 * FF / 256), G, (int)blockIdx.x, wave, worker, nworkers)) tr_run(args, TR_C0, TR_C1, worker, nworkers, lane); }
    }
    SEAM(1);
    if (IN(2)) {
        pg8::Gemm g{ACT, WD1T, M, D, FF}; pg8::StaticOrder S; S.init(M, D, G, (int)blockIdx.x);
        pg8::EpiResidT<true> E{nullptr, XB, nullptr, XB, ssq1, D, 0.5f};
        pg8::gemm_phase<pg8::EpiResidT<true>, pg8::StaticOrder, true, MK_SP2>(lds, g, S, E);
    }
    SEAM(2);
    if (IN(3)) {
        pg8::Gemm g{XB, WINT, M, DIN, D}; pg8::StaticOrder S; S.init(M, DIN, G, (int)blockIdx.x);
        pg8::EpiIn E{UB, GLUB, GATES, args.in[7], ssq1, INVD};
        pg8::gemm_phase<pg8::EpiIn, pg8::StaticOrder, true, MK_SP2>(lds, g, S, E);
        { int worker, nworkers; if (tail_worker((M / 256) * (DIN / 256), G, (int)blockIdx.x, wave, worker, nworkers)) tr_run(args, TR_C1, TR_C2, worker, nworkers, lane); }
    }
    SEAM(3);
    if (IN(4)) {
#ifndef NO_CONV
        for (int it = gw; it < M / 4; it += NGW) p4_conv_item(GLUB, (const bf16*)(ws + DWB_OFF), args.in[12], args.in[13], args.in[14], YB, it, lane);
#endif
#ifndef NO_POOL
        for (int it = gw; it < M / 4; it += NGW) p4_pool_item(UB, PB, it, lane);
#endif
        __syncthreads();
    }
    SEAM(4);
    static_assert(WS_Y == WS_P + (size_t)M * DP * 2 && WS_WCONVT == WS_WPOOLT + (size_t)D * DP * 2 && DP == DC, "P | Y and Wpool_t | Wconv_t are adjacent: the conv unit is a row offset into both operands");
    if (IN(5) && IN(6)) {
        pg8::Gemm g{PB, WPOOLT, 2 * M, 2 * D, DP}; pg8::PairOrder S; S.S.init(M, D, G, (int)blockIdx.x);
        pg8::EpiGateAB E{pg8::EpiGateA{GATES}, pg8::EpiGateB{GATES, args.in[16], MIX}, M / 256, D / 256};
        pg8::gemm_phase<pg8::EpiGateAB, pg8::PairOrder, true, MK_SP2>(lds, g, S, E);
    }
    SEAM(6);
    if (IN(7)) {
        pg8::Gemm g{MIX, WOUTT, M, D, D}; pg8::StaticOrder S; S.init(M, D, G, (int)blockIdx.x);
        pg8::EpiResidT<true> E{nullptr, XB, nullptr, XB, ssq2, D, 1.0f};
        pg8::gemm_phase<pg8::EpiResidT<true>, pg8::StaticOrder, true, MK_SP2>(lds, g, S, E);
    }
    SEAM(7);
    if (IN(8)) {
        pg8::Gemm g{XB, W2T, M, 2 * FF, D}; pg8::StaticOrder S; S.init(M, 2 * FF, G, (int)blockIdx.x);
        pg8::EpiSwiglu E{ACT, FF, ssq2, INVD};
        pg8::gemm_phase<pg8::EpiSwiglu, pg8::StaticOrder, true, MK_SP2>(lds, g, S, E);
        { int worker, nworkers; if (tail_worker((M / 256) * (2 * FF / 256), G, (int)blockIdx.x, wave, worker, nworkers)) tr_run(args, TR_C2, TR_END, worker, nworkers, lane); }
    }
    SEAM(8);
    const bool fuse_final = (G == (M / 256) * (D / 256)) && IN(9) && IN(10);
    if (IN(9)) {
        pg8::Gemm g{ACT, WD2T, M, D, FF}; pg8::StaticOrder S; S.init(M, D, G, (int)blockIdx.x);
        if (fuse_final) {
            pg8::EpiFinal E{XB, out, ssq3, (unsigned*)(ws + CNT_OFF), args.in[22], D, 0.5f, INVD, (unsigned)(D / 256)};
            pg8::gemm_phase<pg8::EpiFinal, pg8::StaticOrder, false, MK_SP2>(lds, g, S, E);
        } else {
            pg8::EpiResidT<true> E{nullptr, XB, out, nullptr, ssq3, D, 0.5f};
            pg8::gemm_phase<pg8::EpiResidT<true>, pg8::StaticOrder, true, MK_SP2>(lds, g, S, E);
        }
    }
    if (!fuse_final) SEAM(9);
    if (IN(10) && !fuse_final) {
        const f32x4* gn = (const f32x4*)args.in[22];
        for (int m = gw; m < M; m += NGW) {
            const float rs = __builtin_amdgcn_rsqf(ssq3[m] * INVD + pg8::RMS_EPS);
            f32x4* xr = (f32x4*)(out + (size_t)m * D);
#pragma unroll
            for (int j = 0; j < 8; ++j) { const f32x4 v = __builtin_nontemporal_load(xr + j * 64 + lane); __builtin_nontemporal_store(v * rs * gn[j * 64 + lane], xr + j * 64 + lane); }
        }
    }
#undef IN
#undef SEAM
}

extern "C" void kernel_launch(void* const* d_in, const int* in_sizes, int n_in, void* d_out, int out_size, void* d_ws, size_t ws_size, hipStream_t stream) {
    static int grid = 0;
    if (grid == 0) {
        if (n_in != 23 || in_sizes[0] != M * D || out_size != M * D || ws_size < WS_END) { fprintf(stderr, "kernel_launch: unexpected shapes / workspace (n_in %d, ws %zu, need %zu)\n", n_in, ws_size, (size_t)WS_END); grid = -1; return; }
        int dev = 0, cus = 0, per_cu = 0;
        if (hipGetDevice(&dev) != hipSuccess || hipDeviceGetAttribute(&cus, hipDeviceAttributeMultiprocessorCount, dev) != hipSuccess) { grid = -1; return; }
        if (hipFuncSetAttribute((const void*)mk_fwd, hipFuncAttributeMaxDynamicSharedMemorySize, LDS_BYTES) != hipSuccess) { fprintf(stderr, "kernel_launch: hipFuncSetAttribute failed\n"); grid = -1; return; }
        if (hipOccupancyMaxActiveBlocksPerMultiprocessor(&per_cu, (const void*)mk_fwd, NTHREADS, LDS_BYTES) != hipSuccess || per_cu < 1) { fprintf(stderr, "kernel_launch: occupancy query reports %d blocks per CU\n", per_cu); (void)hipGetLastError(); grid = -1; return; }
        grid = cus;
    }
    if (grid < 0) return;
    (void)hipMemsetAsync((char*)d_ws + WS_CTL, 0, CTL_ZERO_BYTES, stream);
    Args a{};
    for (int i = 0; i < 23; ++i) a.in[i] = (const float*)d_in[i];
    a.out = (float*)d_out; a.ws = (unsigned char*)d_ws;
#if MK_N_LAUNCHES == 1
    a.ph_lo = 0; a.ph_hi = NPHASES;
    void* params[] = {&a};
    hipError_t e = hipLaunchCooperativeKernel((const void*)mk_fwd, dim3(grid), dim3(NTHREADS), params, LDS_BYTES, stream);
    if (e != hipSuccess) fprintf(stderr, "kernel_launch: cooperative launch failed: %s (grid %d)\n", hipGetErrorString(e), grid);
#else
    for (int ph = 0; ph < NPHASES; ++ph) {
        if (ph == 6) continue;
        a.ph_lo = ph; a.ph_hi = (ph == 5) ? 7 : ph + 1;
        hipLaunchKernelGGL(mk_fwd, dim3(grid), dim3(NTHREADS), LDS_BYTES, stream, a);
    }
#endif
}
```

```cpp
#include <hip/hip_runtime.h>
#include <hip/hip_cooperative_groups.h>
#include <cstdio>
#include <cstdint>
namespace cg = cooperative_groups;
#define MK_N_LAUNCHES 1

namespace pg8 {
#define PG8_LAS __attribute__((address_space(3)))
typedef unsigned short bf16_t;
typedef short bf16x8 __attribute__((ext_vector_type(8)));
typedef float f32x4 __attribute__((ext_vector_type(4)));
typedef unsigned u32x4 __attribute__((ext_vector_type(4)));
constexpr int BM = 256, BK = 64, HALF = 128, HTB = HALF * BK * 2  , STAGE_BYTES = 8 * HTB, NXCD = 8, WGM = 4;

__host__ __device__ __forceinline__ int lds_byte(int r, int c) { const int st = (r >> 4) * 2 + (c >> 5), rr = r & 15, cc = c & 31, ob = rr * 64 + cc * 2; return st * 1024 + (ob ^ (((ob >> 9) & 1) << 5)); }
__host__ __device__ __forceinline__ void stage_rc(int b, int& R, int& C) { const int st = b / 1024, sb = b % 1024, swz = sb ^ (((sb >> 9) & 1) << 5); R = (st >> 1) * 16 + swz / 64; C = (st & 1) * 32 + (swz % 64) / 2; }
__host__ __device__ __forceinline__ int perm32(int rho) { const int n = rho >> 4, i = rho & 15; return 8 * (i >> 2) + 4 * n + (i & 3); }

struct Unit { int pm, pn; };
struct Gemm { const bf16_t* A; const bf16_t* Bt; int M, N, K; };

struct StaticOrder {
    int nM, nN, nwg, G, c;
    __host__ __device__ void init(int M, int N, int G_, int c_) { nM = M / BM; nN = N / BM; nwg = nM * nN; G = G_; c = c_; }
    __host__ __device__ bool next(int i, Unit& u) const {
        const long L = (long)i * G + c; if (L >= nwg) return false;
        int wgid = (int)L; { const int q = nwg / NXCD, r = nwg % NXCD, xcd = wgid % NXCD, off = wgid / NXCD; wgid = (xcd < r ? xcd * (q + 1) : r * (q + 1) + (xcd - r) * q) + off; }
        const int nig = WGM * nN, gid = wgid / nig, fm = gid * WGM, gsz = (nM - fm) < WGM ? (nM - fm) : WGM;
        u.pm = fm + ((wgid % nig) % gsz); u.pn = (wgid % nig) / gsz; return true;
    }
    __device__ __forceinline__ void a_ready(const Unit&) const {}
    __device__ __forceinline__ void done(const Unit&) const {}
};

typedef __bf16 bf16x2_t __attribute__((ext_vector_type(2)));
typedef float f32x2 __attribute__((ext_vector_type(2)));
__device__ __forceinline__ unsigned cvt_pk_bf16(float lo, float hi) { const f32x2 f = {lo, hi}; return __builtin_bit_cast(unsigned, __builtin_convertvector(f, bf16x2_t)); }
template <class Epi, class Sched, bool ALIGN_EPI = false, bool SP2 = false>
__device__ __forceinline__ void gemm_phase(PG8_LAS unsigned char* lds, const Gemm g, const Sched& S, const Epi& E) {
    const int tid = threadIdx.x, wid = __builtin_amdgcn_readfirstlane(tid >> 6), lane = tid & 63, wr = wid >> 2, wc = wid & 3, fr = lane & 15, fq = lane >> 4;
    const int K = g.K, nt = K / BK;
    unsigned voffA[2], voffB[2];
#pragma unroll
    for (int i = 0; i < 2; ++i) { int R, C; stage_rc(tid * 16 + i * 8192, R, C); const int Rb = Epi::PERM ? ((R & ~31) + perm32(R & 31)) : R;
        voffA[i] = (unsigned)(R * K + C) * 2u; voffB[i] = (unsigned)(Rb * K + C) * 2u; }
    const size_t kstep = (size_t)(BK * 2);
    const size_t hstep = (size_t)HALF * K * 2;
    const size_t tstep = 2 * hstep;
    const unsigned ldsw = (unsigned)wid * 1024u;
    const int aoff = lds_byte(wr * 64 + fr, fq * 8), boff = lds_byte(wc * 32 + fr, fq * 8);
#define PG8_SA(b, h) (((b) * 2 + (h)) * HTB)
#define PG8_SB(b, h) ((4 + (b) * 2 + (h)) * HTB)
#define PG8_STAGE(bufoff, gbase, voff) do { _Pragma("unroll") for (int _i = 0; _i < 2; ++_i) \
        __builtin_amdgcn_global_load_lds((const unsigned*)((const char*)(gbase) + (voff)[_i]), (PG8_LAS unsigned*)(lds + (bufoff) + ldsw + _i * 8192), 16, 0, 0); } while (0)
#define PG8_LDA(dst, b, h) do { _Pragma("unroll") for (int m = 0; m < 4; ++m) _Pragma("unroll") for (int k = 0; k < 2; ++k) dst[m][k] = *(const PG8_LAS bf16x8*)(lds + PG8_SA(b, h) + aoff + m * 2048 + k * 1024); } while (0)
#define PG8_LDB(dst, b, h) do { _Pragma("unroll") for (int n = 0; n < 2; ++n) _Pragma("unroll") for (int k = 0; k < 2; ++k) dst[n][k] = *(const PG8_LAS bf16x8*)(lds + PG8_SB(b, h) + boff + n * 2048 + k * 1024); } while (0)
#define PG8_MMA(ai, bj, At, Bt) do { __builtin_amdgcn_s_setprio(1); _Pragma("unroll") for (int m = 0; m < 4; ++m) _Pragma("unroll") for (int n = 0; n < 2; ++n) _Pragma("unroll") for (int k = 0; k < 2; ++k) \
        acc[ai][bj][m][n] = __builtin_amdgcn_mfma_f32_16x16x32_bf16(Bt[n][k], At[m][k], acc[ai][bj][m][n], 0, 0, 0); __builtin_amdgcn_s_setprio(0); } while (0)
#define PG8_WAIT_V(n) asm volatile("s_waitcnt vmcnt(" #n ")" ::: "memory")
#define PG8_WAIT_L(n) asm volatile("s_waitcnt lgkmcnt(" #n ")" ::: "memory")
#define PG8_BAR __builtin_amdgcn_s_barrier()
#define PG8_SCHED __builtin_amdgcn_sched_barrier(0)
    Unit cur, nxt; int ui = 0;
    if (!S.next(0, cur)) return;
    f32x4 acc[2][2][4][2];
#pragma unroll
    for (int a = 0; a < 2; ++a)
#pragma unroll
        for (int b = 0; b < 2; ++b)
#pragma unroll
            for (int m = 0; m < 4; ++m)
#pragma unroll
                for (int n = 0; n < 2; ++n) acc[a][b][m][n] = (f32x4){0.f, 0.f, 0.f, 0.f};
    bf16x8 At[4][2], B0[2][2], B1[2][2];
    const char* cA = (const char*)g.A + (size_t)cur.pm * tstep; const char* cB = (const char*)g.Bt + (size_t)cur.pn * tstep;
    S.a_ready(cur);
    if constexpr (SP2) {
        PG8_STAGE(PG8_SB(0, 0), cB, voffB); PG8_STAGE(PG8_SB(0, 1), cB + hstep, voffB); PG8_STAGE(PG8_SA(0, 0), cA, voffA); PG8_STAGE(PG8_SA(0, 1), cA + hstep, voffA);
        if (wr == 1) PG8_BAR;
        PG8_WAIT_V(2); PG8_BAR;
        PG8_STAGE(PG8_SB(1, 0), cB + kstep, voffB); PG8_STAGE(PG8_SA(1, 0), cA + kstep, voffA); PG8_STAGE(PG8_SB(1, 1), cB + hstep + kstep, voffB);
        PG8_WAIT_V(6); PG8_BAR;
    } else {
        PG8_STAGE(PG8_SB(0, 0), cB, voffB); PG8_STAGE(PG8_SA(0, 0), cA, voffA); PG8_STAGE(PG8_SB(0, 1), cB + hstep, voffB); PG8_STAGE(PG8_SA(0, 1), cA + hstep, voffA);
        if (wr == 1) PG8_BAR;
        PG8_WAIT_V(4); PG8_BAR;
        PG8_STAGE(PG8_SB(1, 0), cB + kstep, voffB); PG8_STAGE(PG8_SA(1, 0), cA + kstep, voffA); PG8_STAGE(PG8_SB(1, 1), cB + hstep + kstep, voffB);
        PG8_WAIT_V(6); PG8_BAR;
    }
    for (;;) {
        const bool has_next = S.next(ui + 1, nxt);
        const char* nA = has_next ? (const char*)g.A + (size_t)nxt.pm * tstep : cA; const char* nB = has_next ? (const char*)g.Bt + (size_t)nxt.pn * tstep : cB;
        for (int t = 0; t < nt; t += 2) {
            const bool last = (t == nt - 2);
            const char* a1 = cA + (size_t)(t + 1) * kstep;
            const char* a2 = last ? nA : cA + (size_t)(t + 2) * kstep; const char* b2 = last ? nB : cB + (size_t)(t + 2) * kstep;
            const char* a3 = a2 + kstep; const char* b3 = b2 + kstep;
            if (last && has_next) S.a_ready(nxt);
            if constexpr (SP2) {
            PG8_LDB(B0, 0, 0); PG8_LDB(B1, 0, 1); PG8_SCHED; PG8_LDA(At, 0, 0); PG8_STAGE(PG8_SA(1, 1), a1 + hstep, voffA);
            PG8_WAIT_V(8); PG8_WAIT_L(0); PG8_BAR; PG8_MMA(0, 0, At, B0); PG8_MMA(0, 1, At, B1); PG8_BAR; PG8_SCHED;
            PG8_LDA(At, 0, 1); PG8_STAGE(PG8_SB(0, 0), b2, voffB); PG8_STAGE(PG8_SB(0, 1), b2 + hstep, voffB); PG8_STAGE(PG8_SA(0, 0), a2, voffA);
            PG8_WAIT_V(8); PG8_WAIT_L(0); PG8_BAR; PG8_MMA(1, 0, At, B0); PG8_MMA(1, 1, At, B1); PG8_BAR; PG8_SCHED;
            PG8_LDB(B0, 1, 0); PG8_LDB(B1, 1, 1); PG8_SCHED; PG8_LDA(At, 1, 0); PG8_STAGE(PG8_SA(0, 1), a2 + hstep, voffA);
            PG8_WAIT_V(8); PG8_WAIT_L(0); PG8_BAR; PG8_MMA(0, 0, At, B0); PG8_MMA(0, 1, At, B1); PG8_BAR; PG8_SCHED;
            PG8_LDA(At, 1, 1); PG8_STAGE(PG8_SB(1, 0), b3, voffB); PG8_STAGE(PG8_SB(1, 1), b3 + hstep, voffB); PG8_STAGE(PG8_SA(1, 0), a3, voffA);
            PG8_WAIT_V(8); PG8_WAIT_L(0); PG8_BAR; PG8_MMA(1, 0, At, B0); PG8_MMA(1, 1, At, B1); PG8_BAR; PG8_SCHED;
            } else {
            PG8_LDB(B0, 0, 0); PG8_SCHED; PG8_LDA(At, 0, 0); PG8_STAGE(PG8_SA(1, 1), a1 + hstep, voffA);
            PG8_WAIT_L(8); PG8_BAR; PG8_WAIT_L(0); PG8_MMA(0, 0, At, B0); PG8_BAR; PG8_SCHED;
            PG8_LDB(B1, 0, 1); PG8_STAGE(PG8_SB(0, 0), b2, voffB);
            PG8_BAR; PG8_WAIT_L(0); PG8_MMA(0, 1, At, B1); PG8_BAR;
            PG8_LDA(At, 0, 1); PG8_STAGE(PG8_SA(0, 0), a2, voffA);
            PG8_BAR; PG8_WAIT_L(0); PG8_MMA(1, 0, At, B0); PG8_BAR; PG8_SCHED;
            PG8_STAGE(PG8_SB(0, 1), b2 + hstep, voffB);
            PG8_WAIT_V(6); PG8_BAR; PG8_MMA(1, 1, At, B1); PG8_BAR;
            PG8_LDB(B0, 1, 0); PG8_SCHED; PG8_LDA(At, 1, 0); PG8_STAGE(PG8_SA(0, 1), a2 + hstep, voffA);
            PG8_WAIT_L(8); PG8_BAR; PG8_WAIT_L(0); PG8_MMA(0, 0, At, B0); PG8_BAR; PG8_SCHED;
            PG8_LDB(B1, 1, 1); PG8_STAGE(PG8_SB(1, 0), b3, voffB);
            PG8_BAR; PG8_WAIT_L(0); PG8_MMA(0, 1, At, B1); PG8_BAR;
            PG8_LDA(At, 1, 1); PG8_STAGE(PG8_SA(1, 0), a3, voffA);
            PG8_BAR; PG8_WAIT_L(0); PG8_MMA(1, 0, At, B0); PG8_BAR; PG8_SCHED;
            PG8_STAGE(PG8_SB(1, 1), b3 + hstep, voffB);
            PG8_WAIT_V(6); PG8_BAR; PG8_MMA(1, 1, At, B1); PG8_BAR;
            }
        }
        if constexpr (ALIGN_EPI) { if (wr == 0) PG8_BAR; }
        bool keep_acc = false;
        if constexpr (!Epi::AFTER_DRAIN) { if constexpr (Epi::CARRY) keep_acc = E.carry(acc, cur, wr, wc, fr, fq); else E(acc, cur, wr, wc, fr, fq); S.done(cur); }
        if (!has_next) break;
        if (!keep_acc) {
#pragma unroll
        for (int a = 0; a < 2; ++a)
#pragma unroll
            for (int b = 0; b < 2; ++b)
#pragma unroll
                for (int m = 0; m < 4; ++m)
#pragma unroll
                    for (int n = 0; n < 2; ++n) acc[a][b][m][n] = (f32x4){0.f, 0.f, 0.f, 0.f};
        }
        cur = nxt; cA = nA; cB = nB; ++ui;
        if constexpr (ALIGN_EPI) { if (wr == 1) PG8_BAR; }
    }
    PG8_WAIT_V(0);
    if constexpr (!ALIGN_EPI) { if (wr == 0) PG8_BAR; }
    PG8_BAR;
    if constexpr (Epi::AFTER_DRAIN) { E.fused(acc, cur, wr, wc, fr, fq, lds, wid, lane); S.done(cur); }
#undef PG8_SA
#undef PG8_SB
#undef PG8_STAGE
#undef PG8_LDA
#undef PG8_LDB
#undef PG8_MMA
#undef PG8_WAIT_V
#undef PG8_WAIT_L
#undef PG8_BAR
#undef PG8_SCHED
}
}

namespace pg8 {
__device__ __forceinline__ float fsigmoid(float x) { return __builtin_amdgcn_rcpf(1.0f + __builtin_amdgcn_exp2f(x * -1.44269504089f)); }
__device__ __forceinline__ float bflo(unsigned w) { return __uint_as_float(w << 16); }
__device__ __forceinline__ float bfhi(unsigned w) { return __uint_as_float(w & 0xffff0000u); }
constexpr float RMS_EPS = 1e-6f;

struct EpiSwiglu {
    static constexpr bool PERM = true, AFTER_DRAIN = false, CARRY = false;
    bf16_t* O; int ldo; const float* ssq; float invd;
    __device__ __forceinline__ void operator()(const f32x4 (&acc)[2][2][4][2], const Unit& u, int wr, int wc, int fr, int fq) const {
        const int row0 = u.pm * BM + wr * 64 + fr, col0 = u.pn * HALF + wc * 32 + 8 * fq;
#pragma unroll
        for (int ai = 0; ai < 2; ++ai)
#pragma unroll
            for (int m = 0; m < 4; ++m) {
                const int row = row0 + ai * HALF + m * 16;
                const float rs = __builtin_amdgcn_rsqf(ssq[row] * invd + RMS_EPS);
                float h[8];
#pragma unroll
                for (int n = 0; n < 2; ++n)
#pragma unroll
                    for (int i = 0; i < 4; ++i) { const float g = acc[ai][0][m][n][i] * rs, up = acc[ai][1][m][n][i] * rs; h[n * 4 + i] = g * fsigmoid(g) * up; }
                u32x4 w; w.x = cvt_pk_bf16(h[0], h[1]); w.y = cvt_pk_bf16(h[2], h[3]); w.z = cvt_pk_bf16(h[4], h[5]); w.w = cvt_pk_bf16(h[6], h[7]);
                *(u32x4*)(O + (size_t)row * ldo + col0) = w;
            }
    }
};

template <bool BF_BASE> struct EpiResidT {
    static constexpr bool PERM = true, AFTER_DRAIN = false, CARRY = false;
    const float* basef; const bf16_t* baseb; float* outf; bf16_t* ob; float* ssq_out; int ldc; float alpha;
    __device__ __forceinline__ void operator()(const f32x4 (&acc)[2][2][4][2], const Unit& u, int wr, int wc, int fr, int fq) const {
        const int row0 = u.pm * BM + wr * 64 + fr, col0 = u.pn * BM + wc * 32 + 8 * fq;
#pragma unroll
        for (int ai = 0; ai < 2; ++ai)
#pragma unroll
            for (int m = 0; m < 4; ++m) {
                const int row = row0 + ai * HALF + m * 16; float s = 0.f;
#pragma unroll
                for (int bj = 0; bj < 2; ++bj) {
                    const size_t off = (size_t)row * ldc + col0 + bj * HALF;
                    f32x4 b0, b1;
                    if constexpr (BF_BASE) { const u32x4 p = *(const u32x4*)(baseb + off); b0 = (f32x4){bflo(p.x), bfhi(p.x), bflo(p.y), bfhi(p.y)}; b1 = (f32x4){bflo(p.z), bfhi(p.z), bflo(p.w), bfhi(p.w)}; }
                    else { b0 = *(const f32x4*)(basef + off); b1 = *(const f32x4*)(basef + off + 4); }
                    const f32x4 v0 = b0 + acc[ai][bj][m][0] * alpha, v1 = b1 + acc[ai][bj][m][1] * alpha;
                    if (outf) { *(f32x4*)(outf + off) = v0; *(f32x4*)(outf + off + 4) = v1; }
                    s += (v0[0] * v0[0] + v0[1] * v0[1]) + (v0[2] * v0[2] + v0[3] * v0[3]) + (v1[0] * v1[0] + v1[1] * v1[1]) + (v1[2] * v1[2] + v1[3] * v1[3]);
                    if (ob) { u32x4 w; w.x = cvt_pk_bf16(v0[0], v0[1]); w.y = cvt_pk_bf16(v0[2], v0[3]); w.z = cvt_pk_bf16(v1[0], v1[1]); w.w = cvt_pk_bf16(v1[2], v1[3]); *(u32x4*)(ob + off) = w; }
                }
                s += __shfl_xor(s, 16); s += __shfl_xor(s, 32);
                if (fq == 0) unsafeAtomicAdd(ssq_out + row, s);
            }
    }
};

struct EpiIn {
    static constexpr bool PERM = true, AFTER_DRAIN = false, CARRY = false;
    bf16_t* U; bf16_t* GLU; bf16_t* GATES; const float* bgate; const float* ssq; float invd;
    __device__ __forceinline__ void operator()(const f32x4 (&acc)[2][2][4][2], const Unit& u, int wr, int wc, int fr, int fq) const {
        const int row0 = u.pm * BM + wr * 64 + fr, cl = wc * 32 + 8 * fq;
        if (u.pn >= 12) {
            const int colb = (u.pn - 12) * HALF + cl;
            f32x4 ba[2], bb[2];
#pragma unroll
            for (int n = 0; n < 2; ++n) { ba[n] = *(const f32x4*)(bgate + colb + 4 * n); bb[n] = *(const f32x4*)(bgate + 2048 + colb + 4 * n); }
#pragma unroll
            for (int ai = 0; ai < 2; ++ai)
#pragma unroll
                for (int m = 0; m < 4; ++m) {
                    const int row = row0 + ai * HALF + m * 16;
                    const float rs = __builtin_amdgcn_rsqf(ssq[row] * invd + RMS_EPS);
                    float hr[8], hb[8];
#pragma unroll
                    for (int n = 0; n < 2; ++n)
#pragma unroll
                        for (int i = 0; i < 4; ++i) {
                            const float ga = fsigmoid(acc[ai][0][m][n][i] * rs + ba[n][i]), gb = fmaxf(fsigmoid(acc[ai][1][m][n][i] * rs + bb[n][i]), 9.0949470177e-13f);
                            hb[n * 4 + i] = gb; hr[n * 4 + i] = ga * __builtin_amdgcn_rcpf(gb);
                        }
                    u32x4 w; w.x = cvt_pk_bf16(hr[0], hr[1]); w.y = cvt_pk_bf16(hr[2], hr[3]); w.z = cvt_pk_bf16(hr[4], hr[5]); w.w = cvt_pk_bf16(hr[6], hr[7]);
                    *(u32x4*)(GATES + (size_t)row * 4096 + colb) = w;
                    w.x = cvt_pk_bf16(hb[0], hb[1]); w.y = cvt_pk_bf16(hb[2], hb[3]); w.z = cvt_pk_bf16(hb[4], hb[5]); w.w = cvt_pk_bf16(hb[6], hb[7]);
                    *(u32x4*)(GATES + (size_t)row * 4096 + 2048 + colb) = w;
                }
        } else if (u.pn >= 4) {
            const int colb = (u.pn - 4) * HALF + cl;
#pragma unroll
            for (int ai = 0; ai < 2; ++ai)
#pragma unroll
                for (int m = 0; m < 4; ++m) {
                    const int row = row0 + ai * HALF + m * 16;
                    const float rs = __builtin_amdgcn_rsqf(ssq[row] * invd + RMS_EPS);
                    float h[8];
#pragma unroll
                    for (int n = 0; n < 2; ++n)
#pragma unroll
                        for (int i = 0; i < 4; ++i) h[n * 4 + i] = (acc[ai][0][m][n][i] * rs) * fsigmoid(acc[ai][1][m][n][i] * rs);
                    u32x4 w; w.x = cvt_pk_bf16(h[0], h[1]); w.y = cvt_pk_bf16(h[2], h[3]); w.z = cvt_pk_bf16(h[4], h[5]); w.w = cvt_pk_bf16(h[6], h[7]);
                    *(u32x4*)(GLU + (size_t)row * 1024 + colb) = w;
                }
        } else {
            const int colb = u.pn * BM + cl;
#pragma unroll
            for (int ai = 0; ai < 2; ++ai)
#pragma unroll
                for (int m = 0; m < 4; ++m) {
                    const int row = row0 + ai * HALF + m * 16;
                    const float rs = __builtin_amdgcn_rsqf(ssq[row] * invd + RMS_EPS);
#pragma unroll
                    for (int bj = 0; bj < 2; ++bj) {
                        const f32x4 v0 = acc[ai][bj][m][0] * rs, v1 = acc[ai][bj][m][1] * rs;
                        u32x4 w; w.x = cvt_pk_bf16(v0[0], v0[1]); w.y = cvt_pk_bf16(v0[2], v0[3]); w.z = cvt_pk_bf16(v1[0], v1[1]); w.w = cvt_pk_bf16(v1[2], v1[3]);
                        *(u32x4*)(U + (size_t)row * 1024 + colb + bj * HALF) = w;
                    }
                }
        }
    }
};

struct EpiGateA {
    static constexpr bool PERM = true, AFTER_DRAIN = false, CARRY = false;
    bf16_t* GATES;
    __device__ __forceinline__ void operator()(const f32x4 (&acc)[2][2][4][2], const Unit& u, int wr, int wc, int fr, int fq) const {
        const int row0 = u.pm * BM + wr * 64 + fr, col0 = u.pn * BM + wc * 32 + 8 * fq;
#pragma unroll
        for (int ai = 0; ai < 2; ++ai)
#pragma unroll
            for (int m = 0; m < 4; ++m) {
                const int row = row0 + ai * HALF + m * 16;
#pragma unroll
                for (int bj = 0; bj < 2; ++bj) {
                    bf16_t* p = GATES + (size_t)row * 4096 + col0 + bj * HALF;
                    const u32x4 g = *(const u32x4*)p;
                    const f32x4 a0 = acc[ai][bj][m][0], a1 = acc[ai][bj][m][1];
                    u32x4 w; w.x = cvt_pk_bf16(bflo(g.x) * a0[0], bfhi(g.x) * a0[1]); w.y = cvt_pk_bf16(bflo(g.y) * a0[2], bfhi(g.y) * a0[3]);
                    w.z = cvt_pk_bf16(bflo(g.z) * a1[0], bfhi(g.z) * a1[1]); w.w = cvt_pk_bf16(bflo(g.w) * a1[2], bfhi(g.w) * a1[3]);
                    *(u32x4*)p = w;
                }
            }
    }
};
struct EpiGateB {
    static constexpr bool PERM = true, AFTER_DRAIN = false, CARRY = false;
    const bf16_t* GATES; const float* bias; bf16_t* MIX;
    __device__ __forceinline__ void operator()(const f32x4 (&acc)[2][2][4][2], const Unit& u, int wr, int wc, int fr, int fq) const {
        const int row0 = u.pm * BM + wr * 64 + fr, col0 = u.pn * BM + wc * 32 + 8 * fq;
        f32x4 bv[2][2];
#pragma unroll
        for (int bj = 0; bj < 2; ++bj)
#pragma unroll
            for (int n = 0; n < 2; ++n) bv[bj][n] = *(const f32x4*)(bias + col0 + bj * HALF + 4 * n);
#pragma unroll
        for (int ai = 0; ai < 2; ++ai)
#pragma unroll
            for (int m = 0; m < 4; ++m) {
                const int row = row0 + ai * HALF + m * 16;
#pragma unroll
                for (int bj = 0; bj < 2; ++bj) {
                    const bf16_t* p = GATES + (size_t)row * 4096 + col0 + bj * HALF;
                    const u32x4 ta = *(const u32x4*)p, g = *(const u32x4*)(p + 2048);
                    const f32x4 a0 = acc[ai][bj][m][0] + bv[bj][0], a1 = acc[ai][bj][m][1] + bv[bj][1];
                    u32x4 w; w.x = cvt_pk_bf16(bflo(ta.x) + bflo(g.x) * a0[0], bfhi(ta.x) + bfhi(g.x) * a0[1]); w.y = cvt_pk_bf16(bflo(ta.y) + bflo(g.y) * a0[2], bfhi(ta.y) + bfhi(g.y) * a0[3]);
                    w.z = cvt_pk_bf16(bflo(ta.z) + bflo(g.z) * a1[0], bfhi(ta.z) + bfhi(g.z) * a1[1]); w.w = cvt_pk_bf16(bflo(ta.w) + bflo(g.w) * a1[2], bfhi(ta.w) + bfhi(g.w) * a1[3]);
                    *(u32x4*)(MIX + (size_t)row * 2048 + col0 + bj * HALF) = w;
                }
            }
    }
};
struct PairOrder {
    StaticOrder S;
    __device__ bool next(int i, Unit& u) const { if (!S.next(i >> 1, u)) return false; if (i & 1) { u.pm += S.nM; u.pn += S.nN; } return true; }
    __device__ __forceinline__ void a_ready(const Unit&) const {}
    __device__ __forceinline__ void done(const Unit&) const {}
};
struct EpiGateAB {
    static constexpr bool PERM = true, AFTER_DRAIN = false, CARRY = true;
    const bf16_t* GATES; const float* bias; bf16_t* MIX; int nM, nN;
    __device__ __forceinline__ bool carry(f32x4 (&acc)[2][2][4][2], const Unit& u, int wr, int wc, int fr, int fq) const {
        const bool first = u.pm < nM;
        const int pm = first ? u.pm : u.pm - nM, pn = first ? u.pn : u.pn - nN;
        const int row0 = pm * BM + wr * 64 + fr, col0 = pn * BM + wc * 32 + 8 * fq;
        if (first) {
#pragma unroll
            for (int ai = 0; ai < 2; ++ai)
#pragma unroll
                for (int m = 0; m < 4; ++m) {
                    const int row = row0 + ai * HALF + m * 16;
#pragma unroll
                    for (int bj = 0; bj < 2; ++bj) {
                        const u32x4 r = *(const u32x4*)(GATES + (size_t)row * 4096 + col0 + bj * HALF);
                        acc[ai][bj][m][0] *= (f32x4){bflo(r.x), bfhi(r.x), bflo(r.y), bfhi(r.y)};
                        acc[ai][bj][m][1] *= (f32x4){bflo(r.z), bfhi(r.z), bflo(r.w), bfhi(r.w)};
                    }
                }
            return true;
        }
        f32x4 bv[2][2];
#pragma unroll
        for (int bj = 0; bj < 2; ++bj)
#pragma unroll
            for (int n = 0; n < 2; ++n) bv[bj][n] = *(const f32x4*)(bias + col0 + bj * HALF + 4 * n);
#pragma unroll
        for (int ai = 0; ai < 2; ++ai)
#pragma unroll
            for (int m = 0; m < 4; ++m) {
                const int row = row0 + ai * HALF + m * 16;
#pragma unroll
                for (int bj = 0; bj < 2; ++bj) {
                    const u32x4 g = *(const u32x4*)(GATES + (size_t)row * 4096 + 2048 + col0 + bj * HALF);
                    const f32x4 v0 = (acc[ai][bj][m][0] + bv[bj][0]) * (f32x4){bflo(g.x), bfhi(g.x), bflo(g.y), bfhi(g.y)}, v1 = (acc[ai][bj][m][1] + bv[bj][1]) * (f32x4){bflo(g.z), bfhi(g.z), bflo(g.w), bfhi(g.w)};
                    u32x4 w; w.x = cvt_pk_bf16(v0[0], v0[1]); w.y = cvt_pk_bf16(v0[2], v0[3]); w.z = cvt_pk_bf16(v1[0], v1[1]); w.w = cvt_pk_bf16(v1[2], v1[3]);
                    *(u32x4*)(MIX + (size_t)row * 2048 + col0 + bj * HALF) = w;
                }
            }
        return false;
    }
};
struct EpiFinal {
    static constexpr bool PERM = true, AFTER_DRAIN = true, CARRY = false;
    const bf16_t* base; float* out; float* ssq; unsigned* cnt; const float* gain; int ldc; float alpha, invd; unsigned ntn;
    __device__ __forceinline__ void fused(f32x4 (&acc)[2][2][4][2], const Unit& u, int wr, int wc, int fr, int fq, PG8_LAS unsigned char* lds, int wid, int lane) const {
        const int row0 = u.pm * BM + wr * 64 + fr, col0 = u.pn * BM + wc * 32 + 8 * fq;
#pragma unroll
        for (int ai = 0; ai < 2; ++ai)
#pragma unroll
            for (int m = 0; m < 4; ++m) {
                const int row = row0 + ai * HALF + m * 16; float s = 0.f;
#pragma unroll
                for (int bj = 0; bj < 2; ++bj) {
                    const size_t off = (size_t)row * ldc + col0 + bj * HALF;
                    const u32x4 p = *(const u32x4*)(base + off);
                    const f32x4 b0 = (f32x4){bflo(p.x), bfhi(p.x), bflo(p.y), bfhi(p.y)}, b1 = (f32x4){bflo(p.z), bfhi(p.z), bflo(p.w), bfhi(p.w)};
                    const f32x4 v0 = b0 + acc[ai][bj][m][0] * alpha, v1 = b1 + acc[ai][bj][m][1] * alpha;
                    acc[ai][bj][m][0] = v0; acc[ai][bj][m][1] = v1;
                    s += (v0[0] * v0[0] + v0[1] * v0[1]) + (v0[2] * v0[2] + v0[3] * v0[3]) + (v1[0] * v1[0] + v1[1] * v1[1]) + (v1[2] * v1[2] + v1[3] * v1[3]);
                }
                s += __shfl_xor(s, 16); s += __shfl_xor(s, 32);
                if (fq == 0) unsafeAtomicAdd(ssq + row, s);
            }
        asm volatile("s_waitcnt vmcnt(0)" ::: "memory");
        __syncthreads();
        if (threadIdx.x == 0) {
            unsigned* c = cnt + 64 * u.pm;
            __builtin_amdgcn_fence(__ATOMIC_RELEASE, "agent");
            __hip_atomic_fetch_add(c, 1u, __ATOMIC_RELAXED, __HIP_MEMORY_SCOPE_AGENT);
            unsigned sp = 0;
            while (__hip_atomic_load(c, __ATOMIC_RELAXED, __HIP_MEMORY_SCOPE_AGENT) < ntn) { __builtin_amdgcn_s_sleep(2); if (++sp > (1u << 22)) break; }
            __builtin_amdgcn_fence(__ATOMIC_ACQUIRE, "agent");
        }
        __syncthreads();
        f32x4 gv[2][2];
#pragma unroll
        for (int bj = 0; bj < 2; ++bj)
#pragma unroll
            for (int n = 0; n < 2; ++n) gv[bj][n] = *(const f32x4*)(gain + col0 + bj * HALF + 4 * n);
#pragma unroll
        for (int ai = 0; ai < 2; ++ai)
#pragma unroll
            for (int m = 0; m < 4; ++m) {
                const int row = row0 + ai * HALF + m * 16;
                const float rs = __builtin_amdgcn_rsqf(__hip_atomic_load(ssq + row, __ATOMIC_RELAXED, __HIP_MEMORY_SCOPE_AGENT) * invd + RMS_EPS);
#pragma unroll
                for (int bj = 0; bj < 2; ++bj) {
                    const size_t off = (size_t)row * ldc + col0 + bj * HALF;
                    __builtin_nontemporal_store(acc[ai][bj][m][0] * rs * gv[bj][0], (f32x4*)(out + off));
                    __builtin_nontemporal_store(acc[ai][bj][m][1] * rs * gv[bj][1], (f32x4*)(out + off + 4));
                }
            }
    }
};
}

#ifndef MK_N_LAUNCHES
#define MK_N_LAUNCHES 1
#endif
#ifndef MK_SP2
#define MK_SP2 true
#endif
constexpr int NWAVES = 8, NTHREADS = NWAVES * 64;
constexpr int NPHASES = 11;
constexpr int BATCH = 2, T = 4096, D = 2048, M = BATCH * T, FF = 5632, DP = 1024, DC = 1024, DIN = 7168, CONVW = 31;

constexpr size_t MiB = 1u << 20;
constexpr size_t WS_CTL = 0, CTL_ZERO_BYTES = 1 * MiB;
constexpr size_t SSQ0_OFF = 65536, SSQ1_OFF = SSQ0_OFF + 32768, SSQ2_OFF = SSQ1_OFF + 32768, SSQ3_OFF = SSQ2_OFF + 32768;
constexpr size_t WS_W1T = 1 * MiB, WS_WD1T = 45 * MiB, WS_WINT = 67 * MiB, WS_WPOOLT = 95 * MiB, WS_WCONVT = 99 * MiB, WS_WOUTT = 103 * MiB, WS_W2T = 111 * MiB, WS_WD2T = 155 * MiB;
constexpr size_t WS_XB = 177 * MiB, WS_ACT = 209 * MiB, WS_GATES = 297 * MiB, WS_END = 361 * MiB;
constexpr size_t WS_U = WS_ACT, WS_GLU = WS_ACT + 16 * MiB, WS_P = WS_ACT + 32 * MiB, WS_Y = WS_ACT + 48 * MiB, WS_MIX = WS_ACT;
static_assert(WS_W1T + (size_t)2 * FF * D * 2 <= WS_WD1T && WS_WD1T + (size_t)D * FF * 2 <= WS_WINT && WS_WINT + (size_t)DIN * D * 2 <= WS_WPOOLT && WS_WOUTT + (size_t)D * D * 2 <= WS_W2T, "ws map");
static_assert(WS_W2T + (size_t)2 * FF * D * 2 <= WS_WD2T && WS_WD2T + (size_t)D * FF * 2 <= WS_XB && WS_XB + (size_t)M * D * 2 <= WS_ACT && WS_ACT + (size_t)M * FF * 2 <= WS_GATES && WS_GATES + (size_t)M * 4096 * 2 <= WS_END, "ws map");

constexpr int RING_BYTES = 131072, LDS_BYTES = 147456;
constexpr int MISC_OFF = LDS_BYTES - 64;
constexpr size_t CNT_OFF = 32768;
constexpr size_t TRCTR_OFF = 49152;
constexpr size_t DWB_OFF = 262144;
constexpr size_t BAR_OFF = 16384;
constexpr int P0_SCR = 16640;

#define LAS __attribute__((address_space(3)))
typedef unsigned short bf16;
typedef unsigned v4u __attribute__((ext_vector_type(4)));
typedef float f32x4 __attribute__((ext_vector_type(4)));
#define LDS_WAIT() asm volatile("s_waitcnt lgkmcnt(0)" ::: "memory")
using pg8::cvt_pk_bf16; using pg8::bflo; using pg8::bfhi; using pg8::fsigmoid;

__device__ __forceinline__ float wave_sum(float v) {
#pragma unroll
    for (int o = 1; o < 64; o <<= 1) v += __shfl_xor(v, o);
    return v;
}
__device__ __forceinline__ int map_row(int mode, int n0) {
    if (mode == 0) return n0;
    if (mode == 1) return ((n0 >> 7) << 8) + (n0 & 127);
    if (mode == 2) return ((n0 >> 7) << 8) + 128 + (n0 & 127);
    if (n0 < 1024) return n0;
    if (n0 >= 3072) { const int j = n0 - 3072; return j < 2048 ? 3072 + ((j >> 7) << 8) + (j & 127) : 3072 + (((j - 2048) >> 7) << 8) + 128 + ((j - 2048) & 127); }
    if (n0 < 2048) { const int j = n0 - 1024; return 1024 + ((j >> 7) << 8) + (j & 127); }
    const int j = n0 - 2048; return 1024 + ((j >> 7) << 8) + 128 + (j & 127);
}
__device__ __forceinline__ void p0_tr_item(const float* __restrict__ W, int K, int N, const float* __restrict__ gain, bf16* __restrict__ WT, int mode, int item, int lane) {
    const int nblk = N >> 7, kb = item / nblk, nb = item - kb * nblk, k0 = (kb << 6) + ((lane >> 5) << 5), n0 = (nb << 7) + ((lane & 31) << 2);
    const float* src = W + (size_t)k0 * N + n0;
    f32x4 v[32];
#pragma unroll
    for (int i = 0; i < 32; ++i) v[i] = __builtin_nontemporal_load((const f32x4*)(src + (size_t)i * N));
    if (gain) {
#pragma unroll
        for (int i = 0; i < 32; ++i) v[i] *= gain[k0 + i];
    }
    bf16* dst = WT + (size_t)map_row(mode, n0) * K + k0;
#pragma unroll
    for (int j = 0; j < 4; ++j)
#pragma unroll
        for (int q = 0; q < 4; ++q) {
            v4u o; o.x = cvt_pk_bf16(v[8 * q + 0][j], v[8 * q + 1][j]); o.y = cvt_pk_bf16(v[8 * q + 2][j], v[8 * q + 3][j]); o.z = cvt_pk_bf16(v[8 * q + 4][j], v[8 * q + 5][j]); o.w = cvt_pk_bf16(v[8 * q + 6][j], v[8 * q + 7][j]);
            *(v4u*)(dst + (size_t)j * K + 8 * q) = o;
        }
}
__device__ __forceinline__ void p0_fold_item(const float* __restrict__ wg, const float* __restrict__ scale, const float* __restrict__ wp, bf16* __restrict__ WPT, int item, LAS float* scr, int lane) {
    const int nb = item & 31, cb = (item >> 5) & 15, g = item >> 9, n0 = nb << 6, c0 = cb << 4;
#pragma unroll
    for (int ci = 0; ci < 16; ++ci) {
        const f32x4 a = *(const f32x4*)(wg + ((size_t)(g * 256 + c0 + ci)) * 256 + lane * 4), s = *(const f32x4*)(scale + g * 256 + lane * 4);
        *(LAS f32x4*)(scr + ci * 256 + lane * 4) = a * s;
    }
    LDS_WAIT(); asm volatile("" ::: "memory");
    float acc[16];
#pragma unroll
    for (int ci = 0; ci < 16; ++ci) acc[ci] = 0.f;
    const float* bp = wp + (size_t)(g * 256) * D + n0 + lane;
    for (int d = 0; d < 256; d += 4) {
        const float b0 = bp[(size_t)(d + 0) * D], b1 = bp[(size_t)(d + 1) * D], b2 = bp[(size_t)(d + 2) * D], b3 = bp[(size_t)(d + 3) * D];
#pragma unroll
        for (int ci = 0; ci < 16; ++ci) { const f32x4 a = *(const LAS f32x4*)(scr + ci * 256 + d); acc[ci] += (a[0] * b0 + a[1] * b1) + (a[2] * b2 + a[3] * b3); }
    }
    v4u o0, o1;
    o0.x = cvt_pk_bf16(acc[0], acc[1]); o0.y = cvt_pk_bf16(acc[2], acc[3]); o0.z = cvt_pk_bf16(acc[4], acc[5]); o0.w = cvt_pk_bf16(acc[6], acc[7]);
    o1.x = cvt_pk_bf16(acc[8], acc[9]); o1.y = cvt_pk_bf16(acc[10], acc[11]); o1.z = cvt_pk_bf16(acc[12], acc[13]); o1.w = cvt_pk_bf16(acc[14], acc[15]);
    bf16* dst = WPT + (size_t)(n0 + lane) * DP + g * 256 + c0;
    *(v4u*)dst = o0; *(v4u*)(dst + 8) = o1;
    LDS_WAIT(); asm volatile("" ::: "memory");
}
__device__ __forceinline__ void unpack8(const v4u w, float (&f)[8]) { f[0] = bflo(w.x); f[1] = bfhi(w.x); f[2] = bflo(w.y); f[3] = bfhi(w.y); f[4] = bflo(w.z); f[5] = bfhi(w.z); f[6] = bflo(w.w); f[7] = bfhi(w.w); }
__device__ __forceinline__ v4u pack8(const float (&f)[8]) { v4u o; o.x = cvt_pk_bf16(f[0], f[1]); o.y = cvt_pk_bf16(f[2], f[3]); o.z = cvt_pk_bf16(f[4], f[5]); o.w = cvt_pk_bf16(f[6], f[7]); return o; }

template <int HMAX>
__device__ __forceinline__ void p4_pool_half(const bf16* __restrict__ ucol, bf16* __restrict__ pcol, int t0, int h) {
    float s[4][8], u[4][8];
#pragma unroll
    for (int r = 0; r < 4; ++r)
#pragma unroll
        for (int i = 0; i < 8; ++i) s[r][i] = 0.f;
#pragma unroll
    for (int jd = -HMAX; jd < 3 + HMAX; ++jd) {
        const int tt = t0 + jd, ttc = tt < 0 ? 0 : (tt >= T ? T - 1 : tt);
        const unsigned msk = (tt == ttc) ? 0xffffffffu : 0u;
        v4u w = *(const v4u*)(ucol + (size_t)ttc * DP);
        w.x &= msk; w.y &= msk; w.z &= msk; w.w &= msk;
        float f[8]; unpack8(w, f);
#pragma unroll
        for (int r = 0; r < 4; ++r) {
            const int rel = jd - r;
            if (rel >= -HMAX && rel < HMAX) {
                const float mk = (rel >= -h && rel < h) ? 1.f : 0.f;
#pragma unroll
                for (int i = 0; i < 8; ++i) s[r][i] += f[i] * mk;
            }
            if (rel == 0) {
#pragma unroll
                for (int i = 0; i < 8; ++i) u[r][i] = f[i];
            }
        }
    }
#pragma unroll
    for (int r = 0; r < 4; ++r) {
        const int t = t0 + r, lo = t - h < 0 ? 0 : t - h, hi = t + h > T ? T : t + h;
        const float inv = 1.0f / (float)(hi - lo);
        float o[8];
#pragma unroll
        for (int i = 0; i < 8; ++i) o[i] = s[r][i] * inv - u[r][i];
        *(v4u*)(pcol + (size_t)t * DP) = pack8(o);
    }
}
__device__ __forceinline__ void p4_pool_item(const bf16* __restrict__ U, bf16* __restrict__ P, int item, int lane) {
    const int r0 = item * 4, b = r0 / T, t0 = r0 - b * T;
    const bf16* ub = U + (size_t)(b * T) * DP; bf16* pb = P + (size_t)(b * T) * DP;
    p4_pool_half<2>(ub + lane * 8, pb + lane * 8, t0, 1 << (lane >> 5));
    p4_pool_half<8>(ub + 512 + lane * 8, pb + 512 + lane * 8, t0, 4 << (lane >> 5));
}
__device__ __forceinline__ const char* uniform_ptr(const void* p) {
    const unsigned long long v = (unsigned long long)p;
    const unsigned lo = __builtin_amdgcn_readfirstlane((unsigned)v), hi = __builtin_amdgcn_readfirstlane((unsigned)(v >> 32));
    return (const char*)(((unsigned long long)hi << 32) | lo);
}
constexpr int CONV_GS = 12, CONV_NG = (CONVW + 3 + CONV_GS) / CONV_GS;
struct ConvGrp { v4u g[CONV_GS], w[CONV_GS]; };
__device__ __forceinline__ void p4_conv_load(ConvGrp& G, const bf16* __restrict__ gbase, const bf16* __restrict__ wbase, int coff, int t0, int jj) {
#pragma unroll
    for (int u = 0; u < CONV_GS; ++u) {
        const int j = jj * CONV_GS + u, jc = j < CONVW ? j : CONVW - 1;
        G.w[u] = *(const v4u*)(uniform_ptr(wbase + jc * DC) + (unsigned)coff * 2u);
        const int t = t0 - 15 + j, tc = t < 0 ? 0 : (t >= T ? T - 1 : t);
        G.g[u] = *(const v4u*)(uniform_ptr(gbase + (size_t)tc * DC) + (unsigned)coff * 2u);
    }
}
__device__ __forceinline__ void p4_conv_half(const bf16* __restrict__ gbase, const bf16* __restrict__ wbase, int coff, int t0, float (&acc)[4][8]) {
    float w[4][8];
#pragma unroll
    for (int u = 0; u < 4; ++u)
#pragma unroll
        for (int i = 0; i < 8; ++i) w[u][i] = 0.f;
#pragma unroll 1
    for (int jj = 0; jj < CONV_NG; ++jj) {
        ConvGrp cur;
        p4_conv_load(cur, gbase, wbase, coff, t0, jj);
#pragma unroll
        for (int u = 0; u < CONV_GS; ++u) {
            const int j = jj * CONV_GS + u, t = t0 - 15 + j;
            const float wm = j < CONVW ? 1.f : 0.f;
            const unsigned msk = (t >= 0 && t < T) ? 0xffffffffu : 0u;
            { float wf[8]; unpack8(cur.w[u], wf);
#pragma unroll
              for (int i = 0; i < 8; ++i) w[u & 3][i] = wf[i] * wm; }
            v4u ga = cur.g[u]; ga.x &= msk; ga.y &= msk; ga.z &= msk; ga.w &= msk;
            float g[8]; unpack8(ga, g);
#pragma unroll
            for (int r = 0; r < 4; ++r)
#pragma unroll
                for (int i = 0; i < 8; ++i) acc[r][i] += w[(u - r) & 3][i] * g[i];
        }
    }
}
__device__ __forceinline__ void p4_conv_item(const bf16* __restrict__ GLU, const bf16* __restrict__ dww, const float* __restrict__ dwb, const float* __restrict__ lng, const float* __restrict__ lnb,
                                             bf16* __restrict__ Y, int item, int lane) {
    const int r0 = item * 4, b = r0 / T, t0 = r0 - b * T;
    const int cA = lane * 8, cB = 512 + lane * 8;
    const bf16* gb = GLU + (size_t)(b * T) * DC;
    float accA[4][8], accB[4][8];
    asm volatile("" ::: "memory");
    {
        const f32x4 b0 = *(const f32x4*)(dwb + cA), b1 = *(const f32x4*)(dwb + cA + 4), b2 = *(const f32x4*)(dwb + cB), b3 = *(const f32x4*)(dwb + cB + 4);
#pragma unroll
        for (int r = 0; r < 4; ++r)
#pragma unroll
            for (int i = 0; i < 4; ++i) { accA[r][i] = b0[i]; accA[r][4 + i] = b1[i]; accB[r][i] = b2[i]; accB[r][4 + i] = b3[i]; }
    }
    p4_conv_half(gb, dww, cA, t0, accA);
    __builtin_amdgcn_sched_barrier(0);
    p4_conv_half(gb, dww, cB, t0, accB);
    f32x4 lg[4], lb[4];
    asm volatile("" ::: "memory");
    lg[0] = *(const f32x4*)(lng + cA); lg[1] = *(const f32x4*)(lng + cA + 4); lg[2] = *(const f32x4*)(lng + cB); lg[3] = *(const f32x4*)(lng + cB + 4);
    lb[0] = *(const f32x4*)(lnb + cA); lb[1] = *(const f32x4*)(lnb + cA + 4); lb[2] = *(const f32x4*)(lnb + cB); lb[3] = *(const f32x4*)(lnb + cB + 4);
#pragma unroll
    for (int r = 0; r < 4; ++r) {
        float s = 0.f;
#pragma unroll
        for (int i = 0; i < 8; ++i) s += accA[r][i] + accB[r][i];
        const float mu = wave_sum(s) * (1.0f / DC);
        float q = 0.f;
#pragma unroll
        for (int i = 0; i < 8; ++i) { accA[r][i] -= mu; accB[r][i] -= mu; q += accA[r][i] * accA[r][i] + accB[r][i] * accB[r][i]; }
        const float rstd = __builtin_amdgcn_rsqf(wave_sum(q) * (1.0f / DC) + pg8::RMS_EPS);
        float oa[8], ob[8];
#pragma unroll
        for (int i = 0; i < 8; ++i) {
            const float ya = accA[r][i] * rstd * lg[i >> 2][i & 3] + lb[i >> 2][i & 3], yb = accB[r][i] * rstd * lg[2 + (i >> 2)][i & 3] + lb[2 + (i >> 2)][i & 3];
            oa[i] = ya * fsigmoid(ya); ob[i] = yb * fsigmoid(yb);
        }
        bf16* yr = Y + (size_t)(r0 + r) * DC;
        *(v4u*)(yr + cA) = pack8(oa); *(v4u*)(yr + cB) = pack8(ob);
    }
}

#define RLX_AGENT __ATOMIC_RELAXED, __HIP_MEMORY_SCOPE_AGENT
#define XB_TMO      128
#define XB_XCNT(j)  (256  + 64 * (j))
#define XB_XSUB(j)  (1280 + 64 * (j))
#define XB_XGEN(j)  (2304 + 64 * (j))
#define XB_TOP      3328
#define XB_TOPGEN   3392
#define XCD_BAR_WORDS 3456
#define XB_SPIN_CAP (1u << 18)

__device__ __forceinline__ unsigned xb_ld(unsigned* p)              { return __hip_atomic_load(p, __ATOMIC_RELAXED, __HIP_MEMORY_SCOPE_AGENT); }
__device__ __forceinline__ unsigned xb_add(unsigned* p, unsigned v) { return __hip_atomic_fetch_add(p, v, __ATOMIC_RELAXED, __HIP_MEMORY_SCOPE_AGENT); }
__device__ __forceinline__ unsigned xb_xcc_id() { return (unsigned)__builtin_amdgcn_s_getreg((3 << 11) | 20) & 0xFu; }
#define XB_SPIN(cond, bar) do { unsigned _sp = 0; while (cond) { __builtin_amdgcn_s_sleep(1); \
    if ((++_sp & 255u) == 0u) { if (xb_ld(&(bar)[XB_TMO])) break; if (_sp > XB_SPIN_CAP) { atomicAdd(&(bar)[XB_TMO], 1u); break; } } } } while (0)

struct XcdBarrier {
    unsigned* bar; unsigned x;
    volatile LAS unsigned* st;
};

__device__ __forceinline__ XcdBarrier xcd_barrier_post(unsigned* bar, volatile LAS unsigned* st) {
    XcdBarrier b; b.bar = bar; b.x = xb_xcc_id(); b.st = st;
    if (threadIdx.x == 0) (void)xb_add(&bar[XB_XCNT(b.x)], 1u);
    return b;
}
__device__ __forceinline__ void xcd_barrier_complete(unsigned* bar, unsigned x, unsigned& nloc, unsigned& nx) {
    const unsigned G = gridDim.x * gridDim.y * gridDim.z;
    unsigned sum, cnt, mine, sp = 0u;
    for (;;) {
        sum = 0u; cnt = 0u; mine = 0u;
#pragma unroll
        for (unsigned j = 0; j < 16; ++j) { const unsigned c = xb_ld(&bar[XB_XCNT(j)]); sum += c; cnt += (c > 0u) ? 1u : 0u; mine = (j == x) ? c : mine; }
        if (sum == G) break;
        __builtin_amdgcn_s_sleep(1);
        if ((++sp & 255u) == 0u) { if (xb_ld(&bar[XB_TMO])) break; if (sp > XB_SPIN_CAP) { atomicAdd(&bar[XB_TMO], 1u); break; } }
    }
    nloc = mine > 0u ? mine : 1u; nx = cnt > 0u ? cnt : 1u;
}

__device__ __forceinline__ void xcd_barrier(const XcdBarrier& b) {
    asm volatile("s_waitcnt vmcnt(0)" ::: "memory");
    __syncthreads();
    if (threadIdx.x == 0) {
        unsigned* bar = b.bar;
        __builtin_amdgcn_s_waitcnt(0);
        unsigned nloc = b.st[0], nx = b.st[1];
        if (nloc == 0u) { xcd_barrier_complete(bar, b.x, nloc, nx); b.st[0] = nloc; b.st[1] = nx; }
        const unsigned old = xb_add(&bar[XB_XSUB(b.x)], 1u);
        const unsigned gen = old / nloc;
        if (old + 1u == (gen + 1u) * nloc) {
            __builtin_amdgcn_fence(__ATOMIC_RELEASE, "agent");
            asm volatile("s_waitcnt vmcnt(0)" ::: "memory");
            const unsigned og = xb_add(&bar[XB_TOP], 1u);
            const unsigned tg = og / nx;
            if (og + 1u == (tg + 1u) * nx) xb_add(&bar[XB_TOPGEN], 1u);
            else XB_SPIN(xb_ld(&bar[XB_TOPGEN]) == tg, bar);
            __builtin_amdgcn_fence(__ATOMIC_ACQUIRE, "agent");
            xb_add(&bar[XB_XGEN(b.x)], 1u);
            asm volatile("s_waitcnt vmcnt(0)" ::: "memory");
        } else {
            XB_SPIN(xb_ld(&bar[XB_XGEN(b.x)]) == gen, bar);
            __builtin_amdgcn_fence(__ATOMIC_ACQUIRE, "agent");
            asm volatile("s_waitcnt vmcnt(0)" ::: "memory");
        }
    }
    __syncthreads();
}
struct Args { const float* in[23]; float* out; unsigned char* ws; int ph_lo, ph_hi; };

constexpr int I_GU = (D / 64) * (FF / 128), I_DN = (FF / 64) * (D / 128), I_IN = (D / 64) * (DIN / 128), I_CV = (DC / 64) * (D / 128), I_WO = (D / 64) * (D / 128), I_FOLD = 4 * 16 * 32;
constexpr int TR_W1U = I_GU, TR_WD1 = 2 * I_GU, TR_WIN = TR_WD1 + I_DN, TR_CV = TR_WIN + I_IN, TR_WO = TR_CV + I_CV, TR_W2G = TR_WO + I_WO, TR_W2U = TR_W2G + I_GU, TR_WD2 = TR_W2U + I_GU, TR_END = TR_WD2 + I_DN;
#ifndef MK_TR_C0
#define MK_TR_C0 TR_WD1
#endif
#ifndef MK_TR_C1
#define MK_TR_C1 TR_W2G
#endif
#ifndef MK_TR_C2
#define MK_TR_C2 TR_WD2
#endif
constexpr int TR_C0 = MK_TR_C0, TR_C1 = MK_TR_C1, TR_C2 = MK_TR_C2;
static_assert(TR_C0 >= TR_WD1 && TR_C1 >= TR_CV && TR_C1 >= TR_C0 && TR_C2 >= TR_C1, "conversion segments follow the phases' dependencies");
__device__ __forceinline__ void tr_run(const Args& args, int lo, int hi, int worker, int nworkers, int lane) {
    unsigned char* ws = args.ws;
    for (int g = lo + worker; g < hi; g += nworkers) {
        if (g < TR_W1U)      p0_tr_item(args.in[2],  D,  FF,  args.in[1],  (bf16*)(ws + WS_W1T),    1, g,          lane);
        else if (g < TR_WD1) p0_tr_item(args.in[3],  D,  FF,  args.in[1],  (bf16*)(ws + WS_W1T),    2, g - TR_W1U, lane);
        else if (g < TR_WIN) p0_tr_item(args.in[4],  FF, D,   nullptr,     (bf16*)(ws + WS_WD1T),   0, g - TR_WD1, lane);
        else if (g < TR_CV)  p0_tr_item(args.in[6],  D,  DIN, args.in[5],  (bf16*)(ws + WS_WINT),   3, g - TR_WIN, lane);
        else if (g < TR_WO)  p0_tr_item(args.in[15], DC, D,   nullptr,     (bf16*)(ws + WS_WCONVT), 0, g - TR_CV,  lane);
        else if (g < TR_W2G) p0_tr_item(args.in[17], D,  D,   nullptr,     (bf16*)(ws + WS_WOUTT),  0, g - TR_WO,  lane);
        else if (g < TR_W2U) p0_tr_item(args.in[19], D,  FF,  args.in[18], (bf16*)(ws + WS_W2T),    1, g - TR_W2G, lane);
        else if (g < TR_WD2) p0_tr_item(args.in[20], D,  FF,  args.in[18], (bf16*)(ws + WS_W2T),    2, g - TR_W2U, lane);
        else                 p0_tr_item(args.in[21], FF, D,   nullptr,     (bf16*)(ws + WS_WD2T),   0, g - TR_WD2, lane);
    }
}
__device__ __forceinline__ void tr_run_dyn(const Args& args, int lo, int hi, unsigned* ctr, int lane) {
    unsigned char* ws = args.ws;
    for (;;) {
        int g = 0;
        if (lane == 0) g = lo + (int)__hip_atomic_fetch_add(ctr, 1u, __ATOMIC_RELAXED, __HIP_MEMORY_SCOPE_AGENT);
        g = __builtin_amdgcn_readfirstlane(g);
        if (g >= hi) break;
        if (g < TR_W1U)      p0_tr_item(args.in[2],  D,  FF,  args.in[1],  (bf16*)(ws + WS_W1T),    1, g,          lane);
        else if (g < TR_WD1) p0_tr_item(args.in[3],  D,  FF,  args.in[1],  (bf16*)(ws + WS_W1T),    2, g - TR_W1U, lane);
        else if (g < TR_WIN) p0_tr_item(args.in[4],  FF, D,   nullptr,     (bf16*)(ws + WS_WD1T),   0, g - TR_WD1, lane);
        else if (g < TR_CV)  p0_tr_item(args.in[6],  D,  DIN, args.in[5],  (bf16*)(ws + WS_WINT),   3, g - TR_WIN, lane);
        else if (g < TR_WO)  p0_tr_item(args.in[15], DC, D,   nullptr,     (bf16*)(ws + WS_WCONVT), 0, g - TR_CV,  lane);
        else if (g < TR_W2G) p0_tr_item(args.in[17], D,  D,   nullptr,     (bf16*)(ws + WS_WOUTT),  0, g - TR_WO,  lane);
        else if (g < TR_W2U) p0_tr_item(args.in[19], D,  FF,  args.in[18], (bf16*)(ws + WS_W2T),    1, g - TR_W2G, lane);
        else if (g < TR_WD2) p0_tr_item(args.in[20], D,  FF,  args.in[18], (bf16*)(ws + WS_W2T),    2, g - TR_W2U, lane);
        else                 p0_tr_item(args.in[21], FF, D,   nullptr,     (bf16*)(ws + WS_WD2T),   0, g - TR_WD2, lane);
    }
}
__device__ __forceinline__ bool tail_worker(int ntiles, int G, int bid, int wave, int& worker, int& nworkers) {
    const int rounds = (ntiles + G - 1) / G, last = ntiles - (rounds - 1) * G;
    if (last == G) { worker = bid * NWAVES + wave; nworkers = G * NWAVES; return true; }
    if (bid < last) return false;
    worker = (bid - last) * NWAVES + wave; nworkers = (G - last) * NWAVES; return true;
}

__global__ void __launch_bounds__(NTHREADS, 2) mk_fwd(Args args) {
    extern __shared__ __attribute__((aligned(16))) unsigned char lds_raw[];
    LAS unsigned char* lds = (LAS unsigned char*)lds_raw;
    cg::grid_group grid = cg::this_grid();
    const int tid = threadIdx.x, lane = tid & 63, wave = __builtin_amdgcn_readfirstlane(tid >> 6);
    const int G = gridDim.x, gw = blockIdx.x * NWAVES + wave, NGW = G * NWAVES;
    unsigned char* ws = args.ws;
    const float* x = args.in[0];
    float* out = args.out;
    float* ssq0 = (float*)(ws + SSQ0_OFF); float* ssq1 = (float*)(ws + SSQ1_OFF); float* ssq2 = (float*)(ws + SSQ2_OFF); float* ssq3 = (float*)(ws + SSQ3_OFF);
    bf16* W1T = (bf16*)(ws + WS_W1T); bf16* WD1T = (bf16*)(ws + WS_WD1T); bf16* WINT = (bf16*)(ws + WS_WINT); bf16* WPOOLT = (bf16*)(ws + WS_WPOOLT); bf16* WCONVT = (bf16*)(ws + WS_WCONVT);
    bf16* WOUTT = (bf16*)(ws + WS_WOUTT); bf16* W2T = (bf16*)(ws + WS_W2T); bf16* WD2T = (bf16*)(ws + WS_WD2T);
    bf16* XB = (bf16*)(ws + WS_XB); bf16* ACT = (bf16*)(ws + WS_ACT); bf16* GATES = (bf16*)(ws + WS_GATES);
    bf16* UB = (bf16*)(ws + WS_U); bf16* GLUB = (bf16*)(ws + WS_GLU); bf16* PB = (bf16*)(ws + WS_P); bf16* YB = (bf16*)(ws + WS_Y); bf16* MIX = (bf16*)(ws + WS_MIX);
    const int lo = args.ph_lo, hi = args.ph_hi;
    if (lo < 0) grid.sync();
    volatile LAS unsigned* MISC = (volatile LAS unsigned*)(lds + MISC_OFF);
    if (tid < 16) MISC[tid] = 0u;
    __syncthreads();
    XcdBarrier bar = xcd_barrier_post((unsigned*)(ws + BAR_OFF), MISC + 8);
#ifndef MK_PHM
#define MK_PHM 0xffffu
#endif
#define IN(k) (((MK_PHM >> (k)) & 1u) && lo <= (k) && (k) < hi)
#ifndef MK_REP
#define MK_REP 0u
#endif
#define REPS(k) (1 + (int)((MK_REP >> (k)) & 1u))
#define SEAM(k) do { if (IN(k) && IN((k) + 1)) xcd_barrier(bar); } while (0)
    constexpr float INVD = 1.0f / D;

    if (IN(0)) {
        LAS float* scr = (LAS float*)(lds + wave * P0_SCR);
        tr_run(args, 0, TR_C0, gw, NGW, lane);
        for (int it = gw; it < I_FOLD; it += NGW) p0_fold_item(args.in[8], args.in[9], args.in[10], WPOOLT, it, scr, lane);
        for (int i = gw * 64 + lane; i < CONVW * DC / 2; i += NGW * 64) ((unsigned*)(ws + DWB_OFF))[i] = cvt_pk_bf16(args.in[11][2 * i], args.in[11][2 * i + 1]);
        for (int m = gw; m < M; m += NGW) {
            const f32x4* xr = (const f32x4*)(x + (size_t)m * D); float s = 0.f;
#pragma unroll
            for (int j = 0; j < 4; ++j) {
                const f32x4 a = __builtin_nontemporal_load(xr + j * 128 + lane * 2), b = __builtin_nontemporal_load(xr + j * 128 + lane * 2 + 1);
                s += (a[0] * a[0] + a[1] * a[1]) + (a[2] * a[2] + a[3] * a[3]) + (b[0] * b[0] + b[1] * b[1]) + (b[2] * b[2] + b[3] * b[3]);
                v4u o; o.x = cvt_pk_bf16(a[0], a[1]); o.y = cvt_pk_bf16(a[2], a[3]); o.z = cvt_pk_bf16(b[0], b[1]); o.w = cvt_pk_bf16(b[2], b[3]);
                *(v4u*)(XB + (size_t)m * D + j * 512 + lane * 8) = o;
            }
            s = wave_sum(s);
            if (lane == 0) ssq0[m] = s;
        }
        __syncthreads();
    }
    SEAM(0);
    if (IN(1)) {
        pg8::Gemm g{XB, W1T, M, 2 * FF, D}; pg8::StaticOrder S; S.init(M, 2 * FF, G, (int)blockIdx.x);
        pg8::EpiSwiglu E{ACT, FF, ssq0, INVD};
        pg8::gemm_phase<pg8::EpiSwiglu, pg8::StaticOrder, true, MK_SP2>(lds, g, S, E);
        { int worker, nworkers; if (tail_worker((M / 256) * (2 * FF / 256), G, (int)blockIdx.x, wave, worker, nworkers)) tr_run(args, TR_C0, TR_C1, worker, nworkers, lane); }
    }
    SEAM(1);
    if (IN(2)) {
        pg8::Gemm g{ACT, WD1T, M, D, FF}; pg8::StaticOrder S; S.init(M, D, G, (int)blockIdx.x);
        pg8::EpiResidT<true> E{nullptr, XB, nullptr, XB, ssq1, D, 0.5f};
        pg8::gemm_phase<pg8::EpiResidT<true>, pg8::StaticOrder, true, MK_SP2>(lds, g, S, E);
    }
    SEAM(2);
    if (IN(3)) {
        pg8::Gemm g{XB, WINT, M, DIN, D}; pg8::StaticOrder S; S.init(M, DIN, G, (int)blockIdx.x);
        pg8::EpiIn E{UB, GLUB, GATES, args.in[7], ssq1, INVD};
        pg8::gemm_phase<pg8::EpiIn, pg8::StaticOrder, true, MK_SP2>(lds, g, S, E);
        { int worker, nworkers; if (tail_worker((M / 256) * (DIN / 256), G, (int)blockIdx.x, wave, worker, nworkers)) tr_run(args, TR_C1, TR_C2, worker, nworkers, lane); }
    }
    SEAM(3);
    if (IN(4)) {
#ifndef NO_CONV
        for (int it = gw; it < M / 4; it += NGW) p4_conv_item(GLUB, (const bf16*)(ws + DWB_OFF), args.in[12], args.in[13], args.in[14], YB, it, lane);
#endif
#ifndef NO_POOL
        for (int it = gw; it < M / 4; it += NGW) p4_pool_item(UB, PB, it, lane);
#endif
        __syncthreads();
    }
    SEAM(4);
    static_assert(WS_Y == WS_P + (size_t)M * DP * 2 && WS_WCONVT == WS_WPOOLT + (size_t)D * DP * 2 && DP == DC, "P | Y and Wpool_t | Wconv_t are adjacent: the conv unit is a row offset into both operands");
    if (IN(5) && IN(6)) {
        pg8::Gemm g{PB, WPOOLT, 2 * M, 2 * D, DP}; pg8::PairOrder S; S.S.init(M, D, G, (int)blockIdx.x);
        pg8::EpiGateAB E{GATES, args.in[16], MIX, M / 256, D / 256};
        pg8::gemm_phase<pg8::EpiGateAB, pg8::PairOrder, true, MK_SP2>(lds, g, S, E);
    }
    SEAM(6);
    if (IN(7)) {
        pg8::Gemm g{MIX, WOUTT, M, D, D}; pg8::StaticOrder S; S.init(M, D, G, (int)blockIdx.x);
        pg8::EpiResidT<true> E{nullptr, XB, nullptr, XB, ssq2, D, 1.0f};
        pg8::gemm_phase<pg8::EpiResidT<true>, pg8::StaticOrder, true, MK_SP2>(lds, g, S, E);
    }
    SEAM(7);
    if (IN(8)) {
        pg8::Gemm g{XB, W2T, M, 2 * FF, D}; pg8::StaticOrder S; S.init(M, 2 * FF, G, (int)blockIdx.x);
        pg8::EpiSwiglu E{ACT, FF, ssq2, INVD};
        pg8::gemm_phase<pg8::EpiSwiglu, pg8::StaticOrder, true, MK_SP2>(lds, g, S, E);
        { int worker, nworkers; if (tail_worker((M / 256) * (2 * FF / 256), G, (int)blockIdx.x, wave, worker, nworkers)) tr_run(args, TR_C2, TR_END, worker, nworkers, lane); }
    }
    SEAM(8);
    const bool fuse_final = (G == (M / 256) * (D / 256)) && IN(9) && IN(10);
    if (IN(9)) {
        pg8::Gemm g{ACT, WD2T, M, D, FF}; pg8::StaticOrder S; S.init(M, D, G, (int)blockIdx.x);
        if (fuse_final) {
            pg8::EpiFinal E{XB, out, ssq3, (unsigned*)(ws + CNT_OFF), args.in[22], D, 0.5f, INVD, (unsigned)(D / 256)};
            pg8::gemm_phase<pg8::EpiFinal, pg8::StaticOrder, false, MK_SP2>(lds, g, S, E);
        } else {
            pg8::EpiResidT<true> E{nullptr, XB, out, nullptr, ssq3, D, 0.5f};
            pg8::gemm_phase<pg8::EpiResidT<true>, pg8::StaticOrder, true, MK_SP2>(lds, g, S, E);
        }
    }
    if (!fuse_final) SEAM(9);
    if (IN(10) && !fuse_final) {
        const f32x4* gn = (const f32x4*)args.in[22];
        for (int m = gw; m < M; m += NGW) {
            const float rs = __builtin_amdgcn_rsqf(ssq3[m] * INVD + pg8::RMS_EPS);
            f32x4* xr = (f32x4*)(out + (size_t)m * D);
#pragma unroll
            for (int j = 0; j < 8; ++j) { const f32x4 v = __builtin_nontemporal_load(xr + j * 64 + lane); __builtin_nontemporal_store(v * rs * gn[j * 64 + lane], xr + j * 64 + lane); }
        }
    }
#undef IN
#undef SEAM
}

extern "C" void kernel_launch(void* const* d_in, const int* in_sizes, int n_in, void* d_out, int out_size, void* d_ws, size_t ws_size, hipStream_t stream) {
    static int grid = 0;
    if (grid == 0) {
        if (n_in != 23 || in_sizes[0] != M * D || out_size != M * D || ws_size < WS_END) { fprintf(stderr, "kernel_launch: unexpected shapes / workspace (n_in %d, ws %zu, need %zu)\n", n_in, ws_size, (size_t)WS_END); grid = -1; return; }
        int dev = 0, cus = 0, per_cu = 0;
        if (hipGetDevice(&dev) != hipSuccess || hipDeviceGetAttribute(&cus, hipDeviceAttributeMultiprocessorCount, dev) != hipSuccess) { grid = -1; return; }
        if (hipFuncSetAttribute((const void*)mk_fwd, hipFuncAttributeMaxDynamicSharedMemorySize, LDS_BYTES) != hipSuccess) { fprintf(stderr, "kernel_launch: hipFuncSetAttribute failed\n"); grid = -1; return; }
        if (hipOccupancyMaxActiveBlocksPerMultiprocessor(&per_cu, (const void*)mk_fwd, NTHREADS, LDS_BYTES) != hipSuccess || per_cu < 1) { fprintf(stderr, "kernel_launch: occupancy query reports %d blocks per CU\n", per_cu); (void)hipGetLastError(); grid = -1; return; }
        grid = cus;
    }
    if (grid < 0) return;
    (void)hipMemsetAsync((char*)d_ws + WS_CTL, 0, CTL_ZERO_BYTES, stream);
    Args a{};
    for (int i = 0; i < 23; ++i) a.in[i] = (const float*)d_in[i];
    a.out = (float*)d_out; a.ws = (unsigned char*)d_ws;
#if MK_N_LAUNCHES == 1
    a.ph_lo = 0; a.ph_hi = NPHASES;
    void* params[] = {&a};
    hipError_t e = hipLaunchCooperativeKernel((const void*)mk_fwd, dim3(grid), dim3(NTHREADS), params, LDS_BYTES, stream);
    if (e != hipSuccess) fprintf(stderr, "kernel_launch: cooperative launch failed: %s (grid %d)\n", hipGetErrorString(e), grid);
#else
    for (int ph = 0; ph < NPHASES; ++ph) {
        if (ph == 6) continue;
        a.ph_lo = ph; a.ph_hi = (ph == 5) ? 7 : ph + 1;
        hipLaunchKernelGGL(mk_fwd, dim3(grid), dim3(NTHREADS), LDS_BYTES, stream, a);
    }
#endif
}
```

```cpp
#include <hip/hip_runtime.h>
#include <hip/hip_cooperative_groups.h>
#include <cstdio>
#include <cstdint>
namespace cg = cooperative_groups;
#define MK_N_LAUNCHES 1

namespace pg8 {
#define PG8_LAS __attribute__((address_space(3)))
typedef unsigned short bf16_t;
typedef short bf16x8 __attribute__((ext_vector_type(8)));
typedef float f32x4 __attribute__((ext_vector_type(4)));
typedef unsigned u32x4 __attribute__((ext_vector_type(4)));
constexpr int BM = 256, BK = 64, HALF = 128, HTB = HALF * BK * 2  , STAGE_BYTES = 8 * HTB, NXCD = 8, WGM = 4;

__host__ __device__ __forceinline__ int lds_byte(int r, int c) { const int st = (r >> 4) * 2 + (c >> 5), rr = r & 15, cc = c & 31, ob = rr * 64 + cc * 2; return st * 1024 + (ob ^ (((ob >> 9) & 1) << 5)); }
__host__ __device__ __forceinline__ void stage_rc(int b, int& R, int& C) { const int st = b / 1024, sb = b % 1024, swz = sb ^ (((sb >> 9) & 1) << 5); R = (st >> 1) * 16 + swz / 64; C = (st & 1) * 32 + (swz % 64) / 2; }
__host__ __device__ __forceinline__ int perm32(int rho) { const int n = rho >> 4, i = rho & 15; return 8 * (i >> 2) + 4 * n + (i & 3); }

struct Unit { int pm, pn; };
struct Gemm { const bf16_t* A; const bf16_t* Bt; int M, N, K; };

struct StaticOrder {
    int nM, nN, nwg, G, c;
    __host__ __device__ void init(int M, int N, int G_, int c_) { nM = M / BM; nN = N / BM; nwg = nM * nN; G = G_; c = c_; }
    __host__ __device__ bool next(int i, Unit& u) const {
        const long L = (long)i * G + c; if (L >= nwg) return false;
        int wgid = (int)L; { const int q = nwg / NXCD, r = nwg % NXCD, xcd = wgid % NXCD, off = wgid / NXCD; wgid = (xcd < r ? xcd * (q + 1) : r * (q + 1) + (xcd - r) * q) + off; }
        const int nig = WGM * nN, gid = wgid / nig, fm = gid * WGM, gsz = (nM - fm) < WGM ? (nM - fm) : WGM;
        u.pm = fm + ((wgid % nig) % gsz); u.pn = (wgid % nig) / gsz; return true;
    }
    __device__ __forceinline__ void a_ready(const Unit&) const {}
    __device__ __forceinline__ void done(const Unit&) const {}
};

typedef __bf16 bf16x2_t __attribute__((ext_vector_type(2)));
typedef float f32x2 __attribute__((ext_vector_type(2)));
__device__ __forceinline__ unsigned cvt_pk_bf16(float lo, float hi) { const f32x2 f = {lo, hi}; return __builtin_bit_cast(unsigned, __builtin_convertvector(f, bf16x2_t)); }
template <class Epi, class Sched, bool ALIGN_EPI = false, bool SP2 = false>
__device__ __forceinline__ void gemm_phase(PG8_LAS unsigned char* lds, const Gemm g, const Sched& S, const Epi& E) {
    const int tid = threadIdx.x, wid = __builtin_amdgcn_readfirstlane(tid >> 6), lane = tid & 63, wr = wid >> 2, wc = wid & 3, fr = lane & 15, fq = lane >> 4;
    const int K = g.K, nt = K / BK;
    unsigned voffA[2], voffB[2];
#pragma unroll
    for (int i = 0; i < 2; ++i) { int R, C; stage_rc(tid * 16 + i * 8192, R, C); const int Rb = Epi::PERM ? ((R & ~31) + perm32(R & 31)) : R;
        voffA[i] = (unsigned)(R * K + C) * 2u; voffB[i] = (unsigned)(Rb * K + C) * 2u; }
    const size_t kstep = (size_t)(BK * 2);
    const size_t hstep = (size_t)HALF * K * 2;
    const size_t tstep = 2 * hstep;
    const unsigned ldsw = (unsigned)wid * 1024u;
    const int aoff = lds_byte(wr * 64 + fr, fq * 8), boff = lds_byte(wc * 32 + fr, fq * 8);
#define PG8_SA(b, h) (((b) * 2 + (h)) * HTB)
#define PG8_SB(b, h) ((4 + (b) * 2 + (h)) * HTB)
#define PG8_STAGE(bufoff, gbase, voff) do { _Pragma("unroll") for (int _i = 0; _i < 2; ++_i) \
        __builtin_amdgcn_global_load_lds((const unsigned*)((const char*)(gbase) + (voff)[_i]), (PG8_LAS unsigned*)(lds + (bufoff) + ldsw + _i * 8192), 16, 0, 0); } while (0)
#define PG8_LDA(dst, b, h) do { _Pragma("unroll") for (int m = 0; m < 4; ++m) _Pragma("unroll") for (int k = 0; k < 2; ++k) dst[m][k] = *(const PG8_LAS bf16x8*)(lds + PG8_SA(b, h) + aoff + m * 2048 + k * 1024); } while (0)
#define PG8_LDB(dst, b, h) do { _Pragma("unroll") for (int n = 0; n < 2; ++n) _Pragma("unroll") for (int k = 0; k < 2; ++k) dst[n][k] = *(const PG8_LAS bf16x8*)(lds + PG8_SB(b, h) + boff + n * 2048 + k * 1024); } while (0)
#define PG8_MMA(ai, bj, At, Bt) do { __builtin_amdgcn_s_setprio(1); _Pragma("unroll") for (int m = 0; m < 4; ++m) _Pragma("unroll") for (int n = 0; n < 2; ++n) _Pragma("unroll") for (int k = 0; k < 2; ++k) \
        acc[ai][bj][m][n] = __builtin_amdgcn_mfma_f32_16x16x32_bf16(Bt[n][k], At[m][k], acc[ai][bj][m][n], 0, 0, 0); __builtin_amdgcn_s_setprio(0); } while (0)
#define PG8_WAIT_V(n) asm volatile("s_waitcnt vmcnt(" #n ")" ::: "memory")
#define PG8_WAIT_L(n) asm volatile("s_waitcnt lgkmcnt(" #n ")" ::: "memory")
#define PG8_BAR __builtin_amdgcn_s_barrier()
#define PG8_SCHED __builtin_amdgcn_sched_barrier(0)
    Unit cur, nxt; int ui = 0;
    if (!S.next(0, cur)) return;
    f32x4 acc[2][2][4][2];
#pragma unroll
    for (int a = 0; a < 2; ++a)
#pragma unroll
        for (int b = 0; b < 2; ++b)
#pragma unroll
            for (int m = 0; m < 4; ++m)
#pragma unroll
                for (int n = 0; n < 2; ++n) acc[a][b][m][n] = (f32x4){0.f, 0.f, 0.f, 0.f};
    bf16x8 At[4][2], B0[2][2], B1[2][2];
    const char* cA = (const char*)g.A + (size_t)cur.pm * tstep; const char* cB = (const char*)g.Bt + (size_t)cur.pn * tstep;
    S.a_ready(cur);
    if constexpr (SP2) {
        PG8_STAGE(PG8_SB(0, 0), cB, voffB); PG8_STAGE(PG8_SB(0, 1), cB + hstep, voffB); PG8_STAGE(PG8_SA(0, 0), cA, voffA); PG8_STAGE(PG8_SA(0, 1), cA + hstep, voffA);
        if (wr == 1) PG8_BAR;
        PG8_WAIT_V(2); PG8_BAR;
        PG8_STAGE(PG8_SB(1, 0), cB + kstep, voffB); PG8_STAGE(PG8_SA(1, 0), cA + kstep, voffA); PG8_STAGE(PG8_SB(1, 1), cB + hstep + kstep, voffB);
        PG8_WAIT_V(6); PG8_BAR;
    } else {
        PG8_STAGE(PG8_SB(0, 0), cB, voffB); PG8_STAGE(PG8_SA(0, 0), cA, voffA); PG8_STAGE(PG8_SB(0, 1), cB + hstep, voffB); PG8_STAGE(PG8_SA(0, 1), cA + hstep, voffA);
        if (wr == 1) PG8_BAR;
        PG8_WAIT_V(4); PG8_BAR;
        PG8_STAGE(PG8_SB(1, 0), cB + kstep, voffB); PG8_STAGE(PG8_SA(1, 0), cA + kstep, voffA); PG8_STAGE(PG8_SB(1, 1), cB + hstep + kstep, voffB);
        PG8_WAIT_V(6); PG8_BAR;
    }
    for (;;) {
        const bool has_next = S.next(ui + 1, nxt);
        const char* nA = has_next ? (const char*)g.A + (size_t)nxt.pm * tstep : cA; const char* nB = has_next ? (const char*)g.Bt + (size_t)nxt.pn * tstep : cB;
        for (int t = 0; t < nt; t += 2) {
            const bool last = (t == nt - 2);
            const char* a1 = cA + (size_t)(t + 1) * kstep;
            const char* a2 = last ? nA : cA + (size_t)(t + 2) * kstep; const char* b2 = last ? nB : cB + (size_t)(t + 2) * kstep;
            const char* a3 = a2 + kstep; const char* b3 = b2 + kstep;
            if (last && has_next) S.a_ready(nxt);
            if constexpr (SP2) {
            PG8_LDB(B0, 0, 0); PG8_LDB(B1, 0, 1); PG8_SCHED; PG8_LDA(At, 0, 0); PG8_STAGE(PG8_SA(1, 1), a1 + hstep, voffA);
            PG8_WAIT_V(8); PG8_WAIT_L(0); PG8_BAR; PG8_MMA(0, 0, At, B0); PG8_MMA(0, 1, At, B1); PG8_BAR; PG8_SCHED;
            PG8_LDA(At, 0, 1); PG8_STAGE(PG8_SB(0, 0), b2, voffB); PG8_STAGE(PG8_SB(0, 1), b2 + hstep, voffB); PG8_STAGE(PG8_SA(0, 0), a2, voffA);
            PG8_WAIT_V(8); PG8_WAIT_L(0); PG8_BAR; PG8_MMA(1, 0, At, B0); PG8_MMA(1, 1, At, B1); PG8_BAR; PG8_SCHED;
            PG8_LDB(B0, 1, 0); PG8_LDB(B1, 1, 1); PG8_SCHED; PG8_LDA(At, 1, 0); PG8_STAGE(PG8_SA(0, 1), a2 + hstep, voffA);
            PG8_WAIT_V(8); PG8_WAIT_L(0); PG8_BAR; PG8_MMA(0, 0, At, B0); PG8_MMA(0, 1, At, B1); PG8_BAR; PG8_SCHED;
            PG8_LDA(At, 1, 1); PG8_STAGE(PG8_SB(1, 0), b3, voffB); PG8_STAGE(PG8_SB(1, 1), b3 + hstep, voffB); PG8_STAGE(PG8_SA(1, 0), a3, voffA);
            PG8_WAIT_V(8); PG8_WAIT_L(0); PG8_BAR; PG8_MMA(1, 0, At, B0); PG8_MMA(1, 1, At, B1); PG8_BAR; PG8_SCHED;
            } else {
            PG8_LDB(B0, 0, 0); PG8_SCHED; PG8_LDA(At, 0, 0); PG8_STAGE(PG8_SA(1, 1), a1 + hstep, voffA);
            PG8_WAIT_L(8); PG8_BAR; PG8_WAIT_L(0); PG8_MMA(0, 0, At, B0); PG8_BAR; PG8_SCHED;
            PG8_LDB(B1, 0, 1); PG8_STAGE(PG8_SB(0, 0), b2, voffB);
            PG8_BAR; PG8_WAIT_L(0); PG8_MMA(0, 1, At, B1); PG8_BAR;
            PG8_LDA(At, 0, 1); PG8_STAGE(PG8_SA(0, 0), a2, voffA);
            PG8_BAR; PG8_WAIT_L(0); PG8_MMA(1, 0, At, B0); PG8_BAR; PG8_SCHED;
            PG8_STAGE(PG8_SB(0, 1), b2 + hstep, voffB);
            PG8_WAIT_V(6); PG8_BAR; PG8_MMA(1, 1, At, B1); PG8_BAR;
            PG8_LDB(B0, 1, 0); PG8_SCHED; PG8_LDA(At, 1, 0); PG8_STAGE(PG8_SA(0, 1), a2 + hstep, voffA);
            PG8_WAIT_L(8); PG8_BAR; PG8_WAIT_L(0); PG8_MMA(0, 0, At, B0); PG8_BAR; PG8_SCHED;
            PG8_LDB(B1, 1, 1); PG8_STAGE(PG8_SB(1, 0), b3, voffB);
            PG8_BAR; PG8_WAIT_L(0); PG8_MMA(0, 1, At, B1); PG8_BAR;
            PG8_LDA(At, 1, 1); PG8_STAGE(PG8_SA(1, 0), a3, voffA);
            PG8_BAR; PG8_WAIT_L(0); PG8_MMA(1, 0, At, B0); PG8_BAR; PG8_SCHED;
            PG8_STAGE(PG8_SB(1, 1), b3 + hstep, voffB);
            PG8_WAIT_V(6); PG8_BAR; PG8_MMA(1, 1, At, B1); PG8_BAR;
            }
        }
        if constexpr (ALIGN_EPI) { if (wr == 0) PG8_BAR; }
        bool keep_acc = false;
        if constexpr (!Epi::AFTER_DRAIN) { if constexpr (Epi::CARRY) keep_acc = E.carry(acc, cur, wr, wc, fr, fq); else E(acc, cur, wr, wc, fr, fq); S.done(cur); }
        if (!has_next) break;
        if (!keep_acc) {
#pragma unroll
        for (int a = 0; a < 2; ++a)
#pragma unroll
            for (int b = 0; b < 2; ++b)
#pragma unroll
                for (int m = 0; m < 4; ++m)
#pragma unroll
                    for (int n = 0; n < 2; ++n) acc[a][b][m][n] = (f32x4){0.f, 0.f, 0.f, 0.f};
        }
        cur = nxt; cA = nA; cB = nB; ++ui;
        if constexpr (ALIGN_EPI) { if (wr == 1) PG8_BAR; }
    }
    PG8_WAIT_V(0);
    if constexpr (!ALIGN_EPI) { if (wr == 0) PG8_BAR; }
    PG8_BAR;
    if constexpr (Epi::AFTER_DRAIN) { E.fused(acc, cur, wr, wc, fr, fq, lds, wid, lane); S.done(cur); }
#undef PG8_SA
#undef PG8_SB
#undef PG8_STAGE
#undef PG8_LDA
#undef PG8_LDB
#undef PG8_MMA
#undef PG8_WAIT_V
#undef PG8_WAIT_L
#undef PG8_BAR
#undef PG8_SCHED
}
}

namespace pg8 {
__device__ __forceinline__ float fsigmoid(float x) { return __builtin_amdgcn_rcpf(1.0f + __builtin_amdgcn_exp2f(x * -1.44269504089f)); }
__device__ __forceinline__ float bflo(unsigned w) { return __uint_as_float(w << 16); }
__device__ __forceinline__ float bfhi(unsigned w) { return __uint_as_float(w & 0xffff0000u); }
constexpr float RMS_EPS = 1e-6f;

struct EpiSwiglu {
    static constexpr bool PERM = true, AFTER_DRAIN = false, CARRY = false;
    bf16_t* O; int ldo; const float* ssq; float invd;
    __device__ __forceinline__ void operator()(const f32x4 (&acc)[2][2][4][2], const Unit& u, int wr, int wc, int fr, int fq) const {
        const int row0 = u.pm * BM + wr * 64 + fr, col0 = u.pn * HALF + wc * 32 + 8 * fq;
#pragma unroll
        for (int ai = 0; ai < 2; ++ai)
#pragma unroll
            for (int m = 0; m < 4; ++m) {
                const int row = row0 + ai * HALF + m * 16;
                const float rs = __builtin_amdgcn_rsqf(ssq[row] * invd + RMS_EPS);
                float h[8];
#pragma unroll
                for (int n = 0; n < 2; ++n)
#pragma unroll
                    for (int i = 0; i < 4; ++i) { const float g = acc[ai][0][m][n][i] * rs, up = acc[ai][1][m][n][i] * rs; h[n * 4 + i] = g * fsigmoid(g) * up; }
                u32x4 w; w.x = cvt_pk_bf16(h[0], h[1]); w.y = cvt_pk_bf16(h[2], h[3]); w.z = cvt_pk_bf16(h[4], h[5]); w.w = cvt_pk_bf16(h[6], h[7]);
                *(u32x4*)(O + (size_t)row * ldo + col0) = w;
            }
    }
};

template <bool BF_BASE> struct EpiResidT {
    static constexpr bool PERM = true, AFTER_DRAIN = false, CARRY = false;
    const float* basef; const bf16_t* baseb; float* outf; bf16_t* ob; float* ssq_out; int ldc; float alpha;
    __device__ __forceinline__ void operator()(const f32x4 (&acc)[2][2][4][2], const Unit& u, int wr, int wc, int fr, int fq) const {
        const int row0 = u.pm * BM + wr * 64 + fr, col0 = u.pn * BM + wc * 32 + 8 * fq;
#pragma unroll
        for (int ai = 0; ai < 2; ++ai)
#pragma unroll
            for (int m = 0; m < 4; ++m) {
                const int row = row0 + ai * HALF + m * 16; float s = 0.f;
#pragma unroll
                for (int bj = 0; bj < 2; ++bj) {
                    const size_t off = (size_t)row * ldc + col0 + bj * HALF;
                    f32x4 b0, b1;
                    if constexpr (BF_BASE) { const u32x4 p = *(const u32x4*)(baseb + off); b0 = (f32x4){bflo(p.x), bfhi(p.x), bflo(p.y), bfhi(p.y)}; b1 = (f32x4){bflo(p.z), bfhi(p.z), bflo(p.w), bfhi(p.w)}; }
                    else { b0 = *(const f32x4*)(basef + off); b1 = *(const f32x4*)(basef + off + 4); }
                    const f32x4 v0 = b0 + acc[ai][bj][m][0] * alpha, v1 = b1 + acc[ai][bj][m][1] * alpha;
                    if (outf) { *(f32x4*)(outf + off) = v0; *(f32x4*)(outf + off + 4) = v1; }
                    s += (v0[0] * v0[0] + v0[1] * v0[1]) + (v0[2] * v0[2] + v0[3] * v0[3]) + (v1[0] * v1[0] + v1[1] * v1[1]) + (v1[2] * v1[2] + v1[3] * v1[3]);
                    if (ob) { u32x4 w; w.x = cvt_pk_bf16(v0[0], v0[1]); w.y = cvt_pk_bf16(v0[2], v0[3]); w.z = cvt_pk_bf16(v1[0], v1[1]); w.w = cvt_pk_bf16(v1[2], v1[3]); *(u32x4*)(ob + off) = w; }
                }
                s += __shfl_xor(s, 16); s += __shfl_xor(s, 32);
                if (fq == 0) unsafeAtomicAdd(ssq_out + row, s);
            }
    }
};

struct EpiIn {
    static constexpr bool PERM = true, AFTER_DRAIN = false, CARRY = false;
    bf16_t* U; bf16_t* GLU; bf16_t* GATES; const float* bgate; const float* ssq; float invd;
    __device__ __forceinline__ void operator()(const f32x4 (&acc)[2][2][4][2], const Unit& u, int wr, int wc, int fr, int fq) const {
        const int row0 = u.pm * BM + wr * 64 + fr, cl = wc * 32 + 8 * fq;
        if (u.pn >= 12) {
            const int colb = (u.pn - 12) * HALF + cl;
            f32x4 ba[2], bb[2];
#pragma unroll
            for (int n = 0; n < 2; ++n) { ba[n] = *(const f32x4*)(bgate + colb + 4 * n); bb[n] = *(const f32x4*)(bgate + 2048 + colb + 4 * n); }
#pragma unroll
            for (int ai = 0; ai < 2; ++ai)
#pragma unroll
                for (int m = 0; m < 4; ++m) {
                    const int row = row0 + ai * HALF + m * 16;
                    const float rs = __builtin_amdgcn_rsqf(ssq[row] * invd + RMS_EPS);
                    float hr[8], hb[8];
#pragma unroll
                    for (int n = 0; n < 2; ++n)
#pragma unroll
                        for (int i = 0; i < 4; ++i) {
                            const float ga = fsigmoid(acc[ai][0][m][n][i] * rs + ba[n][i]), gb = fmaxf(fsigmoid(acc[ai][1][m][n][i] * rs + bb[n][i]), 9.0949470177e-13f);
                            hb[n * 4 + i] = gb; hr[n * 4 + i] = ga * __builtin_amdgcn_rcpf(gb);
                        }
                    u32x4 w; w.x = cvt_pk_bf16(hr[0], hr[1]); w.y = cvt_pk_bf16(hr[2], hr[3]); w.z = cvt_pk_bf16(hr[4], hr[5]); w.w = cvt_pk_bf16(hr[6], hr[7]);
                    *(u32x4*)(GATES + (size_t)row * 4096 + colb) = w;
                    w.x = cvt_pk_bf16(hb[0], hb[1]); w.y = cvt_pk_bf16(hb[2], hb[3]); w.z = cvt_pk_bf16(hb[4], hb[5]); w.w = cvt_pk_bf16(hb[6], hb[7]);
                    *(u32x4*)(GATES + (size_t)row * 4096 + 2048 + colb) = w;
                }
        } else if (u.pn >= 4) {
            const int colb = (u.pn - 4) * HALF + cl;
#pragma unroll
            for (int ai = 0; ai < 2; ++ai)
#pragma unroll
                for (int m = 0; m < 4; ++m) {
                    const int row = row0 + ai * HALF + m * 16;
                    const float rs = __builtin_amdgcn_rsqf(ssq[row] * invd + RMS_EPS);
                    float h[8];
#pragma unroll
                    for (int n = 0; n < 2; ++n)
#pragma unroll
                        for (int i = 0; i < 4; ++i) h[n * 4 + i] = (acc[ai][0][m][n][i] * rs) * fsigmoid(acc[ai][1][m][n][i] * rs);
                    u32x4 w; w.x = cvt_pk_bf16(h[0], h[1]); w.y = cvt_pk_bf16(h[2], h[3]); w.z = cvt_pk_bf16(h[4], h[5]); w.w = cvt_pk_bf16(h[6], h[7]);
                    *(u32x4*)(GLU + (size_t)row * 1024 + colb) = w;
                }
        } else {
            const int colb = u.pn * BM + cl;
#pragma unroll
            for (int ai = 0; ai < 2; ++ai)
#pragma unroll
                for (int m = 0; m < 4; ++m) {
                    const int row = row0 + ai * HALF + m * 16;
                    const float rs = __builtin_amdgcn_rsqf(ssq[row] * invd + RMS_EPS);
#pragma unroll
                    for (int bj = 0; bj < 2; ++bj) {
                        const f32x4 v0 = acc[ai][bj][m][0] * rs, v1 = acc[ai][bj][m][1] * rs;
                        u32x4 w; w.x = cvt_pk_bf16(v0[0], v0[1]); w.y = cvt_pk_bf16(v0[2], v0[3]); w.z = cvt_pk_bf16(v1[0], v1[1]); w.w = cvt_pk_bf16(v1[2], v1[3]);
                        *(u32x4*)(U + (size_t)row * 1024 + colb + bj * HALF) = w;
                    }
                }
        }
    }
};

struct EpiGateA {
    static constexpr bool PERM = true, AFTER_DRAIN = false, CARRY = false;
    bf16_t* GATES;
    __device__ __forceinline__ void operator()(const f32x4 (&acc)[2][2][4][2], const Unit& u, int wr, int wc, int fr, int fq) const {
        const int row0 = u.pm * BM + wr * 64 + fr, col0 = u.pn * BM + wc * 32 + 8 * fq;
#pragma unroll
        for (int ai = 0; ai < 2; ++ai)
#pragma unroll
            for (int m = 0; m < 4; ++m) {
                const int row = row0 + ai * HALF + m * 16;
#pragma unroll
                for (int bj = 0; bj < 2; ++bj) {
                    bf16_t* p = GATES + (size_t)row * 4096 + col0 + bj * HALF;
                    const u32x4 g = *(const u32x4*)p;
                    const f32x4 a0 = acc[ai][bj][m][0], a1 = acc[ai][bj][m][1];
                    u32x4 w; w.x = cvt_pk_bf16(bflo(g.x) * a0[0], bfhi(g.x) * a0[1]); w.y = cvt_pk_bf16(bflo(g.y) * a0[2], bfhi(g.y) * a0[3]);
                    w.z = cvt_pk_bf16(bflo(g.z) * a1[0], bfhi(g.z) * a1[1]); w.w = cvt_pk_bf16(bflo(g.w) * a1[2], bfhi(g.w) * a1[3]);
                    *(u32x4*)p = w;
                }
            }
    }
};
struct EpiGateB {
    static constexpr bool PERM = true, AFTER_DRAIN = false, CARRY = false;
    const bf16_t* GATES; const float* bias; bf16_t* MIX;
    __device__ __forceinline__ void operator()(const f32x4 (&acc)[2][2][4][2], const Unit& u, int wr, int wc, int fr, int fq) const {
        const int row0 = u.pm * BM + wr * 64 + fr, col0 = u.pn * BM + wc * 32 + 8 * fq;
        f32x4 bv[2][2];
#pragma unroll
        for (int bj = 0; bj < 2; ++bj)
#pragma unroll
            for (int n = 0; n < 2; ++n) bv[bj][n] = *(const f32x4*)(bias + col0 + bj * HALF + 4 * n);
#pragma unroll
        for (int ai = 0; ai < 2; ++ai)
#pragma unroll
            for (int m = 0; m < 4; ++m) {
                const int row = row0 + ai * HALF + m * 16;
#pragma unroll
                for (int bj = 0; bj < 2; ++bj) {
                    const bf16_t* p = GATES + (size_t)row * 4096 + col0 + bj * HALF;
                    const u32x4 ta = *(const u32x4*)p, g = *(const u32x4*)(p + 2048);
                    const f32x4 a0 = acc[ai][bj][m][0] + bv[bj][0], a1 = acc[ai][bj][m][1] + bv[bj][1];
                    u32x4 w; w.x = cvt_pk_bf16(bflo(ta.x) + bflo(g.x) * a0[0], bfhi(ta.x) + bfhi(g.x) * a0[1]); w.y = cvt_pk_bf16(bflo(ta.y) + bflo(g.y) * a0[2], bfhi(ta.y) + bfhi(g.y) * a0[3]);
                    w.z = cvt_pk_bf16(bflo(ta.z) + bflo(g.z) * a1[0], bfhi(ta.z) + bfhi(g.z) * a1[1]); w.w = cvt_pk_bf16(bflo(ta.w) + bflo(g.w) * a1[2], bfhi(ta.w) + bfhi(g.w) * a1[3]);
                    *(u32x4*)(MIX + (size_t)row * 2048 + col0 + bj * HALF) = w;
                }
            }
    }
};
struct PairOrder {
    StaticOrder S;
    __device__ bool next(int i, Unit& u) const { if (!S.next(i >> 1, u)) return false; if (i & 1) { u.pm += S.nM; u.pn += S.nN; } return true; }
    __device__ __forceinline__ void a_ready(const Unit&) const {}
    __device__ __forceinline__ void done(const Unit&) const {}
};
struct EpiGateAB {
    static constexpr bool PERM = true, AFTER_DRAIN = false, CARRY = true;
    const bf16_t* GATES; const float* bias; bf16_t* MIX; int nM, nN;
    __device__ __forceinline__ bool carry(f32x4 (&acc)[2][2][4][2], const Unit& u, int wr, int wc, int fr, int fq) const {
        const bool first = u.pm < nM;
        const int pm = first ? u.pm : u.pm - nM, pn = first ? u.pn : u.pn - nN;
        const int row0 = pm * BM + wr * 64 + fr, col0 = pn * BM + wc * 32 + 8 * fq;
        if (first) {
#pragma unroll
            for (int ai = 0; ai < 2; ++ai)
#pragma unroll
                for (int m = 0; m < 4; ++m) {
                    const int row = row0 + ai * HALF + m * 16;
#pragma unroll
                    for (int bj = 0; bj < 2; ++bj) {
                        const u32x4 r = *(const u32x4*)(GATES + (size_t)row * 4096 + col0 + bj * HALF);
                        acc[ai][bj][m][0] *= (f32x4){bflo(r.x), bfhi(r.x), bflo(r.y), bfhi(r.y)};
                        acc[ai][bj][m][1] *= (f32x4){bflo(r.z), bfhi(r.z), bflo(r.w), bfhi(r.w)};
                    }
                }
            return true;
        }
        f32x4 bv[2][2];
#pragma unroll
        for (int bj = 0; bj < 2; ++bj)
#pragma unroll
            for (int n = 0; n < 2; ++n) bv[bj][n] = *(const f32x4*)(bias + col0 + bj * HALF + 4 * n);
#pragma unroll
        for (int ai = 0; ai < 2; ++ai)
#pragma unroll
            for (int m = 0; m < 4; ++m) {
                const int row = row0 + ai * HALF + m * 16;
#pragma unroll
                for (int bj = 0; bj < 2; ++bj) {
                    const u32x4 g = *(const u32x4*)(GATES + (size_t)row * 4096 + 2048 + col0 + bj * HALF);
                    const f32x4 v0 = (acc[ai][bj][m][0] + bv[bj][0]) * (f32x4){bflo(g.x), bfhi(g.x), bflo(g.y), bfhi(g.y)}, v1 = (acc[ai][bj][m][1] + bv[bj][1]) * (f32x4){bflo(g.z), bfhi(g.z), bflo(g.w), bfhi(g.w)};
                    u32x4 w; w.x = cvt_pk_bf16(v0[0], v0[1]); w.y = cvt_pk_bf16(v0[2], v0[3]); w.z = cvt_pk_bf16(v1[0], v1[1]); w.w = cvt_pk_bf16(v1[2], v1[3]);
                    *(u32x4*)(MIX + (size_t)row * 2048 + col0 + bj * HALF) = w;
                }
            }
        return false;
    }
};
struct EpiFinal {
    static constexpr bool PERM = true, AFTER_DRAIN = true, CARRY = false;
    const bf16_t* base; float* out; float* ssq; unsigned* cnt; const float* gain; int ldc; float alpha, invd; unsigned ntn;
    __device__ __forceinline__ void fused(f32x4 (&acc)[2][2][4][2], const Unit& u, int wr, int wc, int fr, int fq, PG8_LAS unsigned char* lds, int wid, int lane) const {
        const int row0 = u.pm * BM + wr * 64 + fr, col0 = u.pn * BM + wc * 32 + 8 * fq;
#pragma unroll
        for (int ai = 0; ai < 2; ++ai)
#pragma unroll
            for (int m = 0; m < 4; ++m) {
                const int row = row0 + ai * HALF + m * 16; float s = 0.f;
#pragma unroll
                for (int bj = 0; bj < 2; ++bj) {
                    const size_t off = (size_t)row * ldc + col0 + bj * HALF;
                    const u32x4 p = *(const u32x4*)(base + off);
                    const f32x4 b0 = (f32x4){bflo(p.x), bfhi(p.x), bflo(p.y), bfhi(p.y)}, b1 = (f32x4){bflo(p.z), bfhi(p.z), bflo(p.w), bfhi(p.w)};
                    const f32x4 v0 = b0 + acc[ai][bj][m][0] * alpha, v1 = b1 + acc[ai][bj][m][1] * alpha;
                    acc[ai][bj][m][0] = v0; acc[ai][bj][m][1] = v1;
                    s += (v0[0] * v0[0] + v0[1] * v0[1]) + (v0[2] * v0[2] + v0[3] * v0[3]) + (v1[0] * v1[0] + v1[1] * v1[1]) + (v1[2] * v1[2] + v1[3] * v1[3]);
                }
                s += __shfl_xor(s, 16); s += __shfl_xor(s, 32);
                if (fq == 0) unsafeAtomicAdd(ssq + row, s);
            }
        asm volatile("s_waitcnt vmcnt(0)" ::: "memory");
        __syncthreads();
        if (threadIdx.x == 0) {
            unsigned* c = cnt + 64 * u.pm;
            __builtin_amdgcn_fence(__ATOMIC_RELEASE, "agent");
            __hip_atomic_fetch_add(c, 1u, __ATOMIC_RELAXED, __HIP_MEMORY_SCOPE_AGENT);
            unsigned sp = 0;
            while (__hip_atomic_load(c, __ATOMIC_RELAXED, __HIP_MEMORY_SCOPE_AGENT) < ntn) { __builtin_amdgcn_s_sleep(2); if (++sp > (1u << 22)) break; }
            __builtin_amdgcn_fence(__ATOMIC_ACQUIRE, "agent");
        }
        __syncthreads();
        f32x4 gv[2][2];
#pragma unroll
        for (int bj = 0; bj < 2; ++bj)
#pragma unroll
            for (int n = 0; n < 2; ++n) gv[bj][n] = *(const f32x4*)(gain + col0 + bj * HALF + 4 * n);
#pragma unroll
        for (int ai = 0; ai < 2; ++ai)
#pragma unroll
            for (int m = 0; m < 4; ++m) {
                const int row = row0 + ai * HALF + m * 16;
                const float rs = __builtin_amdgcn_rsqf(__hip_atomic_load(ssq + row, __ATOMIC_RELAXED, __HIP_MEMORY_SCOPE_AGENT) * invd + RMS_EPS);
#pragma unroll
                for (int bj = 0; bj < 2; ++bj) {
                    const size_t off = (size_t)row * ldc + col0 + bj * HALF;
                    __builtin_nontemporal_store(acc[ai][bj][m][0] * rs * gv[bj][0], (f32x4*)(out + off));
                    __builtin_nontemporal_store(acc[ai][bj][m][1] * rs * gv[bj][1], (f32x4*)(out + off + 4));
                }
            }
    }
};
}

#ifndef MK_N_LAUNCHES
#define MK_N_LAUNCHES 1
#endif
#ifndef MK_SP2
#define MK_SP2 true
#endif
constexpr int NWAVES = 8, NTHREADS = NWAVES * 64;
constexpr int NPHASES = 11;
constexpr int BATCH = 2, T = 4096, D = 2048, M = BATCH * T, FF = 5632, DP = 1024, DC = 1024, DIN = 7168, CONVW = 31;

constexpr size_t MiB = 1u << 20;
constexpr size_t WS_CTL = 0, CTL_ZERO_BYTES = 196608;
constexpr size_t SSQ0_OFF = 65536, SSQ1_OFF = SSQ0_OFF + 32768, SSQ2_OFF = SSQ1_OFF + 32768, SSQ3_OFF = SSQ2_OFF + 32768;
constexpr size_t WS_W1T = 1 * MiB, WS_WD1T = 45 * MiB, WS_WINT = 67 * MiB, WS_WPOOLT = 95 * MiB, WS_WCONVT = 99 * MiB, WS_WOUTT = 103 * MiB, WS_W2T = 111 * MiB, WS_WD2T = 155 * MiB;
constexpr size_t WS_XB = 177 * MiB, WS_ACT = 209 * MiB, WS_GATES = 297 * MiB, WS_END = 361 * MiB;
constexpr size_t WS_U = WS_ACT, WS_GLU = WS_ACT + 16 * MiB, WS_P = WS_ACT + 32 * MiB, WS_Y = WS_ACT + 48 * MiB, WS_MIX = WS_ACT;
static_assert(WS_W1T + (size_t)2 * FF * D * 2 <= WS_WD1T && WS_WD1T + (size_t)D * FF * 2 <= WS_WINT && WS_WINT + (size_t)DIN * D * 2 <= WS_WPOOLT && WS_WOUTT + (size_t)D * D * 2 <= WS_W2T, "ws map");
static_assert(WS_W2T + (size_t)2 * FF * D * 2 <= WS_WD2T && WS_WD2T + (size_t)D * FF * 2 <= WS_XB && WS_XB + (size_t)M * D * 2 <= WS_ACT && WS_ACT + (size_t)M * FF * 2 <= WS_GATES && WS_GATES + (size_t)M * 4096 * 2 <= WS_END, "ws map");

constexpr int RING_BYTES = 131072, LDS_BYTES = 147456;
constexpr int MISC_OFF = LDS_BYTES - 64;
constexpr size_t CNT_OFF = 32768;
constexpr size_t TRCTR_OFF = 49152;
constexpr size_t DWB_OFF = 262144;
constexpr size_t BAR_OFF = 16384;
constexpr int P0_SCR = 16640;

#define LAS __attribute__((address_space(3)))
typedef unsigned short bf16;
typedef unsigned v4u __attribute__((ext_vector_type(4)));
typedef float f32x4 __attribute__((ext_vector_type(4)));
#define LDS_WAIT() asm volatile("s_waitcnt lgkmcnt(0)" ::: "memory")
using pg8::cvt_pk_bf16; using pg8::bflo; using pg8::bfhi; using pg8::fsigmoid;

__device__ __forceinline__ float wave_sum(float v) {
#pragma unroll
    for (int o = 1; o < 64; o <<= 1) v += __shfl_xor(v, o);
    return v;
}
__device__ __forceinline__ int map_row(int mode, int n0) {
    if (mode == 0) return n0;
    if (mode == 1) return ((n0 >> 7) << 8) + (n0 & 127);
    if (mode == 2) return ((n0 >> 7) << 8) + 128 + (n0 & 127);
    if (n0 < 1024) return n0;
    if (n0 >= 3072) { const int j = n0 - 3072; return j < 2048 ? 3072 + ((j >> 7) << 8) + (j & 127) : 3072 + (((j - 2048) >> 7) << 8) + 128 + ((j - 2048) & 127); }
    if (n0 < 2048) { const int j = n0 - 1024; return 1024 + ((j >> 7) << 8) + (j & 127); }
    const int j = n0 - 2048; return 1024 + ((j >> 7) << 8) + 128 + (j & 127);
}
__device__ __forceinline__ void p0_tr_item(const float* __restrict__ W, int K, int N, const float* __restrict__ gain, bf16* __restrict__ WT, int mode, int item, int lane) {
    const int nblk = N >> 7, kb = item / nblk, nb = item - kb * nblk, k0 = (kb << 6) + ((lane >> 5) << 5), n0 = (nb << 7) + ((lane & 31) << 2);
    const float* src = W + (size_t)k0 * N + n0;
    f32x4 v[32];
#pragma unroll
    for (int i = 0; i < 32; ++i) v[i] = __builtin_nontemporal_load((const f32x4*)(src + (size_t)i * N));
    if (gain) {
#pragma unroll
        for (int i = 0; i < 32; ++i) v[i] *= gain[k0 + i];
    }
    bf16* dst = WT + (size_t)map_row(mode, n0) * K + k0;
#pragma unroll
    for (int j = 0; j < 4; ++j)
#pragma unroll
        for (int q = 0; q < 4; ++q) {
            v4u o; o.x = cvt_pk_bf16(v[8 * q + 0][j], v[8 * q + 1][j]); o.y = cvt_pk_bf16(v[8 * q + 2][j], v[8 * q + 3][j]); o.z = cvt_pk_bf16(v[8 * q + 4][j], v[8 * q + 5][j]); o.w = cvt_pk_bf16(v[8 * q + 6][j], v[8 * q + 7][j]);
            *(v4u*)(dst + (size_t)j * K + 8 * q) = o;
        }
}
__device__ __forceinline__ void p0_fold_item(const float* __restrict__ wg, const float* __restrict__ scale, const float* __restrict__ wp, bf16* __restrict__ WPT, int item, LAS float* scr, int lane) {
    const int nb = item & 31, cb = (item >> 5) & 15, g = item >> 9, n0 = nb << 6, c0 = cb << 4;
#pragma unroll
    for (int ci = 0; ci < 16; ++ci) {
        const f32x4 a = *(const f32x4*)(wg + ((size_t)(g * 256 + c0 + ci)) * 256 + lane * 4), s = *(const f32x4*)(scale + g * 256 + lane * 4);
        *(LAS f32x4*)(scr + ci * 256 + lane * 4) = a * s;
    }
    LDS_WAIT(); asm volatile("" ::: "memory");
    float acc[16];
#pragma unroll
    for (int ci = 0; ci < 16; ++ci) acc[ci] = 0.f;
    const float* bp = wp + (size_t)(g * 256) * D + n0 + lane;
    for (int d = 0; d < 256; d += 4) {
        const float b0 = bp[(size_t)(d + 0) * D], b1 = bp[(size_t)(d + 1) * D], b2 = bp[(size_t)(d + 2) * D], b3 = bp[(size_t)(d + 3) * D];
#pragma unroll
        for (int ci = 0; ci < 16; ++ci) { const f32x4 a = *(const LAS f32x4*)(scr + ci * 256 + d); acc[ci] += (a[0] * b0 + a[1] * b1) + (a[2] * b2 + a[3] * b3); }
    }
    v4u o0, o1;
    o0.x = cvt_pk_bf16(acc[0], acc[1]); o0.y = cvt_pk_bf16(acc[2], acc[3]); o0.z = cvt_pk_bf16(acc[4], acc[5]); o0.w = cvt_pk_bf16(acc[6], acc[7]);
    o1.x = cvt_pk_bf16(acc[8], acc[9]); o1.y = cvt_pk_bf16(acc[10], acc[11]); o1.z = cvt_pk_bf16(acc[12], acc[13]); o1.w = cvt_pk_bf16(acc[14], acc[15]);
    bf16* dst = WPT + (size_t)(n0 + lane) * DP + g * 256 + c0;
    *(v4u*)dst = o0; *(v4u*)(dst + 8) = o1;
    LDS_WAIT(); asm volatile("" ::: "memory");
}
__device__ __forceinline__ void unpack8(const v4u w, float (&f)[8]) { f[0] = bflo(w.x); f[1] = bfhi(w.x); f[2] = bflo(w.y); f[3] = bfhi(w.y); f[4] = bflo(w.z); f[5] = bfhi(w.z); f[6] = bflo(w.w); f[7] = bfhi(w.w); }
__device__ __forceinline__ v4u pack8(const float (&f)[8]) { v4u o; o.x = cvt_pk_bf16(f[0], f[1]); o.y = cvt_pk_bf16(f[2], f[3]); o.z = cvt_pk_bf16(f[4], f[5]); o.w = cvt_pk_bf16(f[6], f[7]); return o; }

template <int HMAX>
__device__ __forceinline__ void p4_pool_half(const bf16* __restrict__ ucol, bf16* __restrict__ pcol, int t0, int h) {
    float s[4][8], u[4][8];
#pragma unroll
    for (int r = 0; r < 4; ++r)
#pragma unroll
        for (int i = 0; i < 8; ++i) s[r][i] = 0.f;
#pragma unroll
    for (int jd = -HMAX; jd < 3 + HMAX; ++jd) {
        const int tt = t0 + jd, ttc = tt < 0 ? 0 : (tt >= T ? T - 1 : tt);
        const unsigned msk = (tt == ttc) ? 0xffffffffu : 0u;
        v4u w = *(const v4u*)(ucol + (size_t)ttc * DP);
        w.x &= msk; w.y &= msk; w.z &= msk; w.w &= msk;
        float f[8]; unpack8(w, f);
#pragma unroll
        for (int r = 0; r < 4; ++r) {
            const int rel = jd - r;
            if (rel >= -HMAX && rel < HMAX) {
                const float mk = (rel >= -h && rel < h) ? 1.f : 0.f;
#pragma unroll
                for (int i = 0; i < 8; ++i) s[r][i] += f[i] * mk;
            }
            if (rel == 0) {
#pragma unroll
                for (int i = 0; i < 8; ++i) u[r][i] = f[i];
            }
        }
    }
#pragma unroll
    for (int r = 0; r < 4; ++r) {
        const int t = t0 + r, lo = t - h < 0 ? 0 : t - h, hi = t + h > T ? T : t + h;
        const float inv = 1.0f / (float)(hi - lo);
        float o[8];
#pragma unroll
        for (int i = 0; i < 8; ++i) o[i] = s[r][i] * inv - u[r][i];
        *(v4u*)(pcol + (size_t)t * DP) = pack8(o);
    }
}
__device__ __forceinline__ void p4_pool_item(const bf16* __restrict__ U, bf16* __restrict__ P, int item, int lane) {
    const int r0 = item * 4, b = r0 / T, t0 = r0 - b * T;
    const bf16* ub = U + (size_t)(b * T) * DP; bf16* pb = P + (size_t)(b * T) * DP;
    p4_pool_half<2>(ub + lane * 8, pb + lane * 8, t0, 1 << (lane >> 5));
    p4_pool_half<8>(ub + 512 + lane * 8, pb + 512 + lane * 8, t0, 4 << (lane >> 5));
}
__device__ __forceinline__ const char* uniform_ptr(const void* p) {
    const unsigned long long v = (unsigned long long)p;
    const unsigned lo = __builtin_amdgcn_readfirstlane((unsigned)v), hi = __builtin_amdgcn_readfirstlane((unsigned)(v >> 32));
    return (const char*)(((unsigned long long)hi << 32) | lo);
}
constexpr int CONV_GS = 12, CONV_NG = (CONVW + 3 + CONV_GS) / CONV_GS;
struct ConvGrp { v4u g[CONV_GS], w[CONV_GS]; };
__device__ __forceinline__ void p4_conv_load(ConvGrp& G, const bf16* __restrict__ gbase, const bf16* __restrict__ wbase, int coff, int t0, int jj) {
#pragma unroll
    for (int u = 0; u < CONV_GS; ++u) {
        const int j = jj * CONV_GS + u, jc = j < CONVW ? j : CONVW - 1;
        G.w[u] = *(const v4u*)(uniform_ptr(wbase + jc * DC) + (unsigned)coff * 2u);
        const int t = t0 - 15 + j, tc = t < 0 ? 0 : (t >= T ? T - 1 : t);
        G.g[u] = *(const v4u*)(uniform_ptr(gbase + (size_t)tc * DC) + (unsigned)coff * 2u);
    }
}
__device__ __forceinline__ void p4_conv_half(const bf16* __restrict__ gbase, const bf16* __restrict__ wbase, int coff, int t0, float (&acc)[4][8]) {
    float w[4][8];
#pragma unroll
    for (int u = 0; u < 4; ++u)
#pragma unroll
        for (int i = 0; i < 8; ++i) w[u][i] = 0.f;
#pragma unroll 1
    for (int jj = 0; jj < CONV_NG; ++jj) {
        ConvGrp cur;
        p4_conv_load(cur, gbase, wbase, coff, t0, jj);
#pragma unroll
        for (int u = 0; u < CONV_GS; ++u) {
            const int j = jj * CONV_GS + u, t = t0 - 15 + j;
            const float wm = j < CONVW ? 1.f : 0.f;
            const unsigned msk = (t >= 0 && t < T) ? 0xffffffffu : 0u;
            { float wf[8]; unpack8(cur.w[u], wf);
#pragma unroll
              for (int i = 0; i < 8; ++i) w[u & 3][i] = wf[i] * wm; }
            v4u ga = cur.g[u]; ga.x &= msk; ga.y &= msk; ga.z &= msk; ga.w &= msk;
            float g[8]; unpack8(ga, g);
#pragma unroll
            for (int r = 0; r < 4; ++r)
#pragma unroll
                for (int i = 0; i < 8; ++i) acc[r][i] += w[(u - r) & 3][i] * g[i];
        }
    }
}
__device__ __forceinline__ void p4_conv_item(const bf16* __restrict__ GLU, const bf16* __restrict__ dww, const float* __restrict__ dwb, const float* __restrict__ lng, const float* __restrict__ lnb,
                                             bf16* __restrict__ Y, int item, int lane) {
    const int r0 = item * 4, b = r0 / T, t0 = r0 - b * T;
    const int cA = lane * 8, cB = 512 + lane * 8;
    const bf16* gb = GLU + (size_t)(b * T) * DC;
    float accA[4][8], accB[4][8];
    asm volatile("" ::: "memory");
    {
        const f32x4 b0 = *(const f32x4*)(dwb + cA), b1 = *(const f32x4*)(dwb + cA + 4), b2 = *(const f32x4*)(dwb + cB), b3 = *(const f32x4*)(dwb + cB + 4);
#pragma unroll
        for (int r = 0; r < 4; ++r)
#pragma unroll
            for (int i = 0; i < 4; ++i) { accA[r][i] = b0[i]; accA[r][4 + i] = b1[i]; accB[r][i] = b2[i]; accB[r][4 + i] = b3[i]; }
    }
    p4_conv_half(gb, dww, cA, t0, accA);
    __builtin_amdgcn_sched_barrier(0);
    p4_conv_half(gb, dww, cB, t0, accB);
    f32x4 lg[4], lb[4];
    asm volatile("" ::: "memory");
    lg[0] = *(const f32x4*)(lng + cA); lg[1] = *(const f32x4*)(lng + cA + 4); lg[2] = *(const f32x4*)(lng + cB); lg[3] = *(const f32x4*)(lng + cB + 4);
    lb[0] = *(const f32x4*)(lnb + cA); lb[1] = *(const f32x4*)(lnb + cA + 4); lb[2] = *(const f32x4*)(lnb + cB); lb[3] = *(const f32x4*)(lnb + cB + 4);
#pragma unroll
    for (int r = 0; r < 4; ++r) {
        float s = 0.f;
#pragma unroll
        for (int i = 0; i < 8; ++i) s += accA[r][i] + accB[r][i];
        const float mu = wave_sum(s) * (1.0f / DC);
        float q = 0.f;
#pragma unroll
        for (int i = 0; i < 8; ++i) { accA[r][i] -= mu; accB[r][i] -= mu; q += accA[r][i] * accA[r][i] + accB[r][i] * accB[r][i]; }
        const float rstd = __builtin_amdgcn_rsqf(wave_sum(q) * (1.0f / DC) + pg8::RMS_EPS);
        float oa[8], ob[8];
#pragma unroll
        for (int i = 0; i < 8; ++i) {
            const float ya = accA[r][i] * rstd * lg[i >> 2][i & 3] + lb[i >> 2][i & 3], yb = accB[r][i] * rstd * lg[2 + (i >> 2)][i & 3] + lb[2 + (i >> 2)][i & 3];
            oa[i] = ya * fsigmoid(ya); ob[i] = yb * fsigmoid(yb);
        }
        bf16* yr = Y + (size_t)(r0 + r) * DC;
        *(v4u*)(yr + cA) = pack8(oa); *(v4u*)(yr + cB) = pack8(ob);
    }
}

#define RLX_AGENT __ATOMIC_RELAXED, __HIP_MEMORY_SCOPE_AGENT
#define XB_TMO      128
#define XB_XCNT(j)  (256  + 64 * (j))
#define XB_XSUB(j)  (1280 + 64 * (j))
#define XB_XGEN(j)  (2304 + 64 * (j))
#define XB_TOP      3328
#define XB_TOPGEN   3392
#define XCD_BAR_WORDS 3456
#define XB_SPIN_CAP (1u << 18)

__device__ __forceinline__ unsigned xb_ld(unsigned* p)              { return __hip_atomic_load(p, __ATOMIC_RELAXED, __HIP_MEMORY_SCOPE_AGENT); }
__device__ __forceinline__ unsigned xb_add(unsigned* p, unsigned v) { return __hip_atomic_fetch_add(p, v, __ATOMIC_RELAXED, __HIP_MEMORY_SCOPE_AGENT); }
__device__ __forceinline__ unsigned xb_xcc_id() { return (unsigned)__builtin_amdgcn_s_getreg((3 << 11) | 20) & 0xFu; }
#define XB_SPIN(cond, bar) do { unsigned _sp = 0; while (cond) { __builtin_amdgcn_s_sleep(1); \
    if ((++_sp & 255u) == 0u) { if (xb_ld(&(bar)[XB_TMO])) break; if (_sp > XB_SPIN_CAP) { atomicAdd(&(bar)[XB_TMO], 1u); break; } } } } while (0)

struct XcdBarrier {
    unsigned* bar; unsigned x;
    volatile LAS unsigned* st;
};

__device__ __forceinline__ XcdBarrier xcd_barrier_post(unsigned* bar, volatile LAS unsigned* st) {
    XcdBarrier b; b.bar = bar; b.x = xb_xcc_id(); b.st = st;
    if (threadIdx.x == 0) (void)xb_add(&bar[XB_XCNT(b.x)], 1u);
    return b;
}
__device__ __forceinline__ void xcd_barrier_complete(unsigned* bar, unsigned x, unsigned& nloc, unsigned& nx) {
    const unsigned G = gridDim.x * gridDim.y * gridDim.z;
    unsigned sum, cnt, mine, sp = 0u;
    for (;;) {
        sum = 0u; cnt = 0u; mine = 0u;
#pragma unroll
        for (unsigned j = 0; j < 16; ++j) { const unsigned c = xb_ld(&bar[XB_XCNT(j)]); sum += c; cnt += (c > 0u) ? 1u : 0u; mine = (j == x) ? c : mine; }
        if (sum == G) break;
        __builtin_amdgcn_s_sleep(1);
        if ((++sp & 255u) == 0u) { if (xb_ld(&bar[XB_TMO])) break; if (sp > XB_SPIN_CAP) { atomicAdd(&bar[XB_TMO], 1u); break; } }
    }
    nloc = mine > 0u ? mine : 1u; nx = cnt > 0u ? cnt : 1u;
}

__device__ __forceinline__ void xcd_barrier(const XcdBarrier& b) {
    asm volatile("s_waitcnt vmcnt(0)" ::: "memory");
    __syncthreads();
    if (threadIdx.x == 0) {
        unsigned* bar = b.bar;
        __builtin_amdgcn_s_waitcnt(0);
        unsigned nloc = b.st[0], nx = b.st[1];
        if (nloc == 0u) { xcd_barrier_complete(bar, b.x, nloc, nx); b.st[0] = nloc; b.st[1] = nx; }
        const unsigned old = xb_add(&bar[XB_XSUB(b.x)], 1u);
        const unsigned gen = old / nloc;
        if (old + 1u == (gen + 1u) * nloc) {
            __builtin_amdgcn_fence(__ATOMIC_RELEASE, "agent");
            asm volatile("s_waitcnt vmcnt(0)" ::: "memory");
            const unsigned og = xb_add(&bar[XB_TOP], 1u);
            const unsigned tg = og / nx;
            if (og + 1u == (tg + 1u) * nx) xb_add(&bar[XB_TOPGEN], 1u);
            else XB_SPIN(xb_ld(&bar[XB_TOPGEN]) == tg, bar);
            __builtin_amdgcn_fence(__ATOMIC_ACQUIRE, "agent");
            xb_add(&bar[XB_XGEN(b.x)], 1u);
            asm volatile("s_waitcnt vmcnt(0)" ::: "memory");
        } else {
            XB_SPIN(xb_ld(&bar[XB_XGEN(b.x)]) == gen, bar);
            __builtin_amdgcn_fence(__ATOMIC_ACQUIRE, "agent");
            asm volatile("s_waitcnt vmcnt(0)" ::: "memory");
        }
    }
    __syncthreads();
}
struct Args { const float* in[23]; float* out; unsigned char* ws; int ph_lo, ph_hi; };

constexpr int I_GU = (D / 64) * (FF / 128), I_DN = (FF / 64) * (D / 128), I_IN = (D / 64) * (DIN / 128), I_CV = (DC / 64) * (D / 128), I_WO = (D / 64) * (D / 128), I_FOLD = 4 * 16 * 32;
constexpr int TR_W1U = I_GU, TR_WD1 = 2 * I_GU, TR_WIN = TR_WD1 + I_DN, TR_CV = TR_WIN + I_IN, TR_WO = TR_CV + I_CV, TR_W2G = TR_WO + I_WO, TR_W2U = TR_W2G + I_GU, TR_WD2 = TR_W2U + I_GU, TR_END = TR_WD2 + I_DN;
#ifndef MK_TR_C0
#define MK_TR_C0 TR_WD1
#endif
#ifndef MK_TR_C1
#define MK_TR_C1 TR_W2G
#endif
#ifndef MK_TR_C2
#define MK_TR_C2 TR_WD2
#endif
constexpr int TR_C0 = MK_TR_C0, TR_C1 = MK_TR_C1, TR_C2 = MK_TR_C2;
static_assert(TR_C0 >= TR_WD1 && TR_C1 >= TR_CV && TR_C1 >= TR_C0 && TR_C2 >= TR_C1, "conversion segments follow the phases' dependencies");
__device__ __forceinline__ void tr_run(const Args& args, int lo, int hi, int worker, int nworkers, int lane) {
    unsigned char* ws = args.ws;
    for (int g = lo + worker; g < hi; g += nworkers) {
        if (g < TR_W1U)      p0_tr_item(args.in[2],  D,  FF,  args.in[1],  (bf16*)(ws + WS_W1T),    1, g,          lane);
        else if (g < TR_WD1) p0_tr_item(args.in[3],  D,  FF,  args.in[1],  (bf16*)(ws + WS_W1T),    2, g - TR_W1U, lane);
        else if (g < TR_WIN) p0_tr_item(args.in[4],  FF, D,   nullptr,     (bf16*)(ws + WS_WD1T),   0, g - TR_WD1, lane);
        else if (g < TR_CV)  p0_tr_item(args.in[6],  D,  DIN, args.in[5],  (bf16*)(ws + WS_WINT),   3, g - TR_WIN, lane);
        else if (g < TR_WO)  p0_tr_item(args.in[15], DC, D,   nullptr,     (bf16*)(ws + WS_WCONVT), 0, g - TR_CV,  lane);
        else if (g < TR_W2G) p0_tr_item(args.in[17], D,  D,   nullptr,     (bf16*)(ws + WS_WOUTT),  0, g - TR_WO,  lane);
        else if (g < TR_W2U) p0_tr_item(args.in[19], D,  FF,  args.in[18], (bf16*)(ws + WS_W2T),    1, g - TR_W2G, lane);
        else if (g < TR_WD2) p0_tr_item(args.in[20], D,  FF,  args.in[18], (bf16*)(ws + WS_W2T),    2, g - TR_W2U, lane);
        else                 p0_tr_item(args.in[21], FF, D,   nullptr,     (bf16*)(ws + WS_WD2T),   0, g - TR_WD2, lane);
    }
}
__device__ __forceinline__ void tr_run_dyn(const Args& args, int lo, int hi, unsigned* ctr, int lane) {
    unsigned char* ws = args.ws;
    for (;;) {
        int g = 0;
        if (lane == 0) g = lo + (int)__hip_atomic_fetch_add(ctr, 1u, __ATOMIC_RELAXED, __HIP_MEMORY_SCOPE_AGENT);
        g = __builtin_amdgcn_readfirstlane(g);
        if (g >= hi) break;
        if (g < TR_W1U)      p0_tr_item(args.in[2],  D,  FF,  args.in[1],  (bf16*)(ws + WS_W1T),    1, g,          lane);
        else if (g < TR_WD1) p0_tr_item(args.in[3],  D,  FF,  args.in[1],  (bf16*)(ws + WS_W1T),    2, g - TR_W1U, lane);
        else if (g < TR_WIN) p0_tr_item(args.in[4],  FF, D,   nullptr,     (bf16*)(ws + WS_WD1T),   0, g - TR_WD1, lane);
        else if (g < TR_CV)  p0_tr_item(args.in[6],  D,  DIN, args.in[5],  (bf16*)(ws + WS_WINT),   3, g - TR_WIN, lane);
        else if (g < TR_WO)  p0_tr_item(args.in[15], DC, D,   nullptr,     (bf16*)(ws + WS_WCONVT), 0, g - TR_CV,  lane);
        else if (g < TR_W2G) p0_tr_item(args.in[17], D,  D,   nullptr,     (bf16*)(ws + WS_WOUTT),  0, g - TR_WO,  lane);
        else if (g < TR_W2U) p0_tr_item(args.in[19], D,  FF,  args.in[18], (bf16*)(ws + WS_W2T),    1, g - TR_W2G, lane);
        else if (g < TR_WD2) p0_tr_item(args.in[20], D,  FF,  args.in[18], (bf16*)(ws + WS_W2T),    2, g - TR_W2U, lane);
        else                 p0_tr_item(args.in[21], FF, D,   nullptr,     (bf16*)(ws + WS_WD2T),   0, g - TR_WD2, lane);
    }
}
__device__ __forceinline__ bool tail_worker(int ntiles, int G, int bid, int wave, int& worker, int& nworkers) {
    const int rounds = (ntiles + G - 1) / G, last = ntiles - (rounds - 1) * G;
    if (last == G) { worker = bid * NWAVES + wave; nworkers = G * NWAVES; return true; }
    if (bid < last) return false;
    worker = (bid - last) * NWAVES + wave; nworkers = (G - last) * NWAVES; return true;
}

__global__ void __launch_bounds__(NTHREADS, 2) mk_fwd(Args args) {
    extern __shared__ __attribute__((aligned(16))) unsigned char lds_raw[];
    LAS unsigned char* lds = (LAS unsigned char*)lds_raw;
    cg::grid_group grid = cg::this_grid();
    const int tid = threadIdx.x, lane = tid & 63, wave = __builtin_amdgcn_readfirstlane(tid >> 6);
    const int G = gridDim.x, gw = blockIdx.x * NWAVES + wave, NGW = G * NWAVES;
    unsigned char* ws = args.ws;
    const float* x = args.in[0];
    float* out = args.out;
    float* ssq0 = (float*)(ws + SSQ0_OFF); float* ssq1 = (float*)(ws + SSQ1_OFF); float* ssq2 = (float*)(ws + SSQ2_OFF); float* ssq3 = (float*)(ws + SSQ3_OFF);
    bf16* W1T = (bf16*)(ws + WS_W1T); bf16* WD1T = (bf16*)(ws + WS_WD1T); bf16* WINT = (bf16*)(ws + WS_WINT); bf16* WPOOLT = (bf16*)(ws + WS_WPOOLT); bf16* WCONVT = (bf16*)(ws + WS_WCONVT);
    bf16* WOUTT = (bf16*)(ws + WS_WOUTT); bf16* W2T = (bf16*)(ws + WS_W2T); bf16* WD2T = (bf16*)(ws + WS_WD2T);
    bf16* XB = (bf16*)(ws + WS_XB); bf16* ACT = (bf16*)(ws + WS_ACT); bf16* GATES = (bf16*)(ws + WS_GATES);
    bf16* UB = (bf16*)(ws + WS_U); bf16* GLUB = (bf16*)(ws + WS_GLU); bf16* PB = (bf16*)(ws + WS_P); bf16* YB = (bf16*)(ws + WS_Y); bf16* MIX = (bf16*)(ws + WS_MIX);
    const int lo = args.ph_lo, hi = args.ph_hi;
    if (lo < 0) grid.sync();
    volatile LAS unsigned* MISC = (volatile LAS unsigned*)(lds + MISC_OFF);
    if (tid < 16) MISC[tid] = 0u;
    __syncthreads();
    XcdBarrier bar = xcd_barrier_post((unsigned*)(ws + BAR_OFF), MISC + 8);
#ifndef MK_PHM
#define MK_PHM 0xffffu
#endif
#define IN(k) (((MK_PHM >> (k)) & 1u) && lo <= (k) && (k) < hi)
#ifndef MK_REP
#define MK_REP 0u
#endif
#define REPS(k) (1 + (int)((MK_REP >> (k)) & 1u))
#define SEAM(k) do { if (IN(k) && IN((k) + 1)) xcd_barrier(bar); } while (0)
    constexpr float INVD = 1.0f / D;

    if (IN(0)) {
        LAS float* scr = (LAS float*)(lds + wave * P0_SCR);
        tr_run(args, 0, TR_C0, gw, NGW, lane);
        for (int it = gw; it < I_FOLD; it += NGW) p0_fold_item(args.in[8], args.in[9], args.in[10], WPOOLT, it, scr, lane);
        for (int i = gw * 64 + lane; i < CONVW * DC / 2; i += NGW * 64) ((unsigned*)(ws + DWB_OFF))[i] = cvt_pk_bf16(args.in[11][2 * i], args.in[11][2 * i + 1]);
        for (int m = gw; m < M; m += NGW) {
            const f32x4* xr = (const f32x4*)(x + (size_t)m * D); float s = 0.f;
#pragma unroll
            for (int j = 0; j < 4; ++j) {
                const f32x4 a = __builtin_nontemporal_load(xr + j * 128 + lane * 2), b = __builtin_nontemporal_load(xr + j * 128 + lane * 2 + 1);
                s += (a[0] * a[0] + a[1] * a[1]) + (a[2] * a[2] + a[3] * a[3]) + (b[0] * b[0] + b[1] * b[1]) + (b[2] * b[2] + b[3] * b[3]);
                v4u o; o.x = cvt_pk_bf16(a[0], a[1]); o.y = cvt_pk_bf16(a[2], a[3]); o.z = cvt_pk_bf16(b[0], b[1]); o.w = cvt_pk_bf16(b[2], b[3]);
                *(v4u*)(XB + (size_t)m * D + j * 512 + lane * 8) = o;
            }
            s = wave_sum(s);
            if (lane == 0) ssq0[m] = s;
        }
        __syncthreads();
    }
    SEAM(0);
    if (IN(1)) {
        pg8::Gemm g{XB, W1T, M, 2 * FF, D}; pg8::StaticOrder S; S.init(M, 2 * FF, G, (int)blockIdx.x);
        pg8::EpiSwiglu E{ACT, FF, ssq0, INVD};
        pg8::gemm_phase<pg8::EpiSwiglu, pg8::StaticOrder, true, MK_SP2>(lds, g, S, E);
        { int worker, nworkers; if (tail_worker((M / 256) * (2 * FF / 256), G, (int)blockIdx.x, wave, worker, nworkers)) tr_run(args, TR_C0, TR_C1, worker, nworkers, lane); }
    }
    SEAM(1);
    if (IN(2)) {
        pg8::Gemm g{ACT, WD1T, M, D, FF}; pg8::StaticOrder S; S.init(M, D, G, (int)blockIdx.x);
        pg8::EpiResidT<true> E{nullptr, XB, nullptr, XB, ssq1, D, 0.5f};
        pg8::gemm_phase<pg8::EpiResidT<true>, pg8::StaticOrder, true, MK_SP2>(lds, g, S, E);
    }
    SEAM(2);
    if (IN(3)) {
        pg8::Gemm g{XB, WINT, M, DIN, D}; pg8::StaticOrder S; S.init(M, DIN, G, (int)blockIdx.x);
        pg8::EpiIn E{UB, GLUB, GATES, args.in[7], ssq1, INVD};
        pg8::gemm_phase<pg8::EpiIn, pg8::StaticOrder, true, MK_SP2>(lds, g, S, E);
        { int worker, nworkers; if (tail_worker((M / 256) * (DIN / 256), G, (int)blockIdx.x, wave, worker, nworkers)) tr_run(args, TR_C1, TR_C2, worker, nworkers, lane); }
    }
    SEAM(3);
    if (IN(4)) {
#ifndef NO_CONV
        for (int it = gw; it < M / 4; it += NGW) p4_conv_item(GLUB, (const bf16*)(ws + DWB_OFF), args.in[12], args.in[13], args.in[14], YB, it, lane);
#endif
#ifndef NO_POOL
        for (int it = gw; it < M / 4; it += NGW) p4_pool_item(UB, PB, it, lane);
#endif
        __syncthreads();
    }
    SEAM(4);
    static_assert(WS_Y == WS_P + (size_t)M * DP * 2 && WS_WCONVT == WS_WPOOLT + (size_t)D * DP * 2 && DP == DC, "P | Y and Wpool_t | Wconv_t are adjacent: the conv unit is a row offset into both operands");
    if (IN(5) && IN(6)) {
        pg8::Gemm g{PB, WPOOLT, 2 * M, 2 * D, DP}; pg8::PairOrder S; S.S.init(M, D, G, (int)blockIdx.x);
        pg8::EpiGateAB E{GATES, args.in[16], MIX, M / 256, D / 256};
        pg8::gemm_phase<pg8::EpiGateAB, pg8::PairOrder, true, MK_SP2>(lds, g, S, E);
    }
    SEAM(6);
    if (IN(7)) {
        pg8::Gemm g{MIX, WOUTT, M, D, D}; pg8::StaticOrder S; S.init(M, D, G, (int)blockIdx.x);
        pg8::EpiResidT<true> E{nullptr, XB, nullptr, XB, ssq2, D, 1.0f};
        pg8::gemm_phase<pg8::EpiResidT<true>, pg8::StaticOrder, true, MK_SP2>(lds, g, S, E);
    }
    SEAM(7);
    if (IN(8)) {
        pg8::Gemm g{XB, W2T, M, 2 * FF, D}; pg8::StaticOrder S; S.init(M, 2 * FF, G, (int)blockIdx.x);
        pg8::EpiSwiglu E{ACT, FF, ssq2, INVD};
        pg8::gemm_phase<pg8::EpiSwiglu, pg8::StaticOrder, true, MK_SP2>(lds, g, S, E);
        { int worker, nworkers; if (tail_worker((M / 256) * (2 * FF / 256), G, (int)blockIdx.x, wave, worker, nworkers)) tr_run(args, TR_C2, TR_END, worker, nworkers, lane); }
    }
    SEAM(8);
    const bool fuse_final = (G == (M / 256) * (D / 256)) && IN(9) && IN(10);
    if (IN(9)) {
        pg8::Gemm g{ACT, WD2T, M, D, FF}; pg8::StaticOrder S; S.init(M, D, G, (int)blockIdx.x);
        if (fuse_final) {
            pg8::EpiFinal E{XB, out, ssq3, (unsigned*)(ws + CNT_OFF), args.in[22], D, 0.5f, INVD, (unsigned)(D / 256)};
            pg8::gemm_phase<pg8::EpiFinal, pg8::StaticOrder, false, MK_SP2>(lds, g, S, E);
        } else {
            pg8::EpiResidT<true> E{nullptr, XB, out, nullptr, ssq3, D, 0.5f};
            pg8::gemm_phase<pg8::EpiResidT<true>, pg8::StaticOrder, true, MK_SP2>(lds, g, S, E);
        }
    }
    if (!fuse_final) SEAM(9);
    if (IN(10) && !fuse_final) {
        const f32x4* gn = (const f32x4*)args.in[22];
        for (int m = gw; m < M; m += NGW) {
            const float rs = __builtin_amdgcn_rsqf(ssq3[m] * INVD + pg8::RMS_EPS);
            f32x4* xr = (f32x4*)(out + (size_t)m * D);
#pragma unroll
            for (int j = 0; j < 8; ++j) { const f32x4 v = __builtin_nontemporal_load(xr + j * 64 + lane); __builtin_nontemporal_store(v * rs * gn[j * 64 + lane], xr + j * 64 + lane); }
        }
    }
#undef IN
#undef SEAM
}

extern "C" void kernel_launch(void* const* d_in, const int* in_sizes, int n_in, void* d_out, int out_size, void* d_ws, size_t ws_size, hipStream_t stream) {
    static int grid = 0;
    if (grid == 0) {
        if (n_in != 23 || in_sizes[0] != M * D || out_size != M * D || ws_size < WS_END) { fprintf(stderr, "kernel_launch: unexpected shapes / workspace (n_in %d, ws %zu, need %zu)\n", n_in, ws_size, (size_t)WS_END); grid = -1; return; }
        int dev = 0, cus = 0, per_cu = 0;
        if (hipGetDevice(&dev) != hipSuccess || hipDeviceGetAttribute(&cus, hipDeviceAttributeMultiprocessorCount, dev) != hipSuccess) { grid = -1; return; }
        if (hipFuncSetAttribute((const void*)mk_fwd, hipFuncAttributeMaxDynamicSharedMemorySize, LDS_BYTES) != hipSuccess) { fprintf(stderr, "kernel_launch: hipFuncSetAttribute failed\n"); grid = -1; return; }
        if (hipOccupancyMaxActiveBlocksPerMultiprocessor(&per_cu, (const void*)mk_fwd, NTHREADS, LDS_BYTES) != hipSuccess || per_cu < 1) { fprintf(stderr, "kernel_launch: occupancy query reports %d blocks per CU\n", per_cu); (void)hipGetLastError(); grid = -1; return; }
        grid = cus;
    }
    if (grid < 0) return;
    (void)hipMemsetAsync((char*)d_ws + WS_CTL, 0, CTL_ZERO_BYTES, stream);
    Args a{};
    for (int i = 0; i < 23; ++i) a.in[i] = (const float*)d_in[i];
    a.out = (float*)d_out; a.ws = (unsigned char*)d_ws;
#if MK_N_LAUNCHES == 1
    a.ph_lo = 0; a.ph_hi = NPHASES;
    void* params[] = {&a};
    hipError_t e = hipLaunchCooperativeKernel((const void*)mk_fwd, dim3(grid), dim3(NTHREADS), params, LDS_BYTES, stream);
    if (e != hipSuccess) fprintf(stderr, "kernel_launch: cooperative launch failed: %s (grid %d)\n", hipGetErrorString(e), grid);
#else
    for (int ph = 0; ph < NPHASES; ++ph) {
        if (ph == 6) continue;
        a.ph_lo = ph; a.ph_hi = (ph == 5) ? 7 : ph + 1;
        hipLaunchKernelGGL(mk_fwd, dim3(grid), dim3(NTHREADS), LDS_BYTES, stream, a);
    }
#endif
}
```
